# Optimizing an MI355X kernel written in HIP

```python
import jax, jax.numpy as jnp
from jax import lax
import numpy as np

D_MODEL = 2048
BATCH = 8
SEQ = 2048
DEPTH = 2

N_MIXERS = 2
HEAD_DIM = 128
HEADS_PER_GROUP = 4
DILATED_PATTERNS = ((128, 1), (512, 4), (2048, 16))
N_ATTN_GROUPS = len(DILATED_PATTERNS)
N_HEADS = HEADS_PER_GROUP * N_ATTN_GROUPS
ATTN_WIDTH = N_HEADS * HEAD_DIM
ROT_DIM = HEAD_DIM // 4
ROPE_THETA = 500000.0
ATTN_BLOCK = 64
NEG_INF = -1e30
FOURIER_GROUPS = 8
FOURIER_GROUP_DIM = D_MODEL // FOURIER_GROUPS
N_EXPERT_GROUPS = 8
EXPERTS_PER_GROUP = 8
N_EXPERTS = N_EXPERT_GROUPS * EXPERTS_PER_GROUP
TOP_K_INNER = 2
D_EXPERT = D_MODEL // 4
MOE_BLOCK = 128
EPS = 1e-6
N_ATTN_LAYERS = (DEPTH + 1) // 2
N_FOURIER_LAYERS = DEPTH // 2

kernel_name = "hybrid_dilated_fourier_hmoe_encoder"


def rmsnorm(x, g):
    xf = x.astype(jnp.float32)
    y = xf * lax.rsqrt(jnp.mean(xf * xf, axis=-1, keepdims=True) + EPS)
    return (y * g.astype(jnp.float32)).astype(x.dtype)


def partial_rope(t, seq_len):
    half = ROT_DIM // 2
    inv_freq = ROPE_THETA ** (-jnp.arange(0, ROT_DIM, 2, dtype=jnp.float32) / ROT_DIM)
    ang = jnp.arange(seq_len, dtype=jnp.float32)[:, None] * inv_freq[None, :]
    cos = jnp.cos(ang)[None, :, None, :]
    sin = jnp.sin(ang)[None, :, None, :]
    tf = t.astype(jnp.float32)
    t1, t2, rest = tf[..., :half], tf[..., half:ROT_DIM], tf[..., ROT_DIM:]
    out = jnp.concatenate([t1 * cos - t2 * sin, t2 * cos + t1 * sin, rest], axis=-1)
    return out.astype(t.dtype)


def dilated_window_attention(q, k, v, window, dilation):
    b_, s_, h_, dh = q.shape
    radius = (window // 2) // dilation
    length = s_ // dilation
    nb = -(-length // ATTN_BLOCK)
    lp = nb * ATTN_BLOCK
    kspan = ATTN_BLOCK + 2 * radius

    def phase(t):
        return t.reshape(b_, length, dilation, h_, dh).transpose(0, 2, 3, 1, 4).astype(jnp.float32)

    qs, ks, vs = phase(q), phase(k), phase(v)
    qb = jnp.pad(qs, ((0, 0), (0, 0), (0, 0), (0, lp - length), (0, 0)))
    qb = qb.reshape(b_, dilation, h_, nb, ATTN_BLOCK, dh)
    pad_kv = ((0, 0), (0, 0), (0, 0), (radius, lp - length + radius), (0, 0))
    idx = np.arange(nb)[:, None] * ATTN_BLOCK + np.arange(kspan)[None, :]
    kb = jnp.take(jnp.pad(ks, pad_kv), idx, axis=3)
    vb = jnp.take(jnp.pad(vs, pad_kv), idx, axis=3)

    jq = np.arange(nb)[:, None] * ATTN_BLOCK + np.arange(ATTN_BLOCK)[None, :]
    jk = np.arange(nb)[:, None] * ATTN_BLOCK + np.arange(kspan)[None, :] - radius
    valid = (np.abs(jk[:, None, :] - jq[:, :, None]) <= radius) & (jk[:, None, :] >= 0) & (jk[:, None, :] < length)

    s = jnp.einsum('bdhnqc,bdhnkc->bdhnqk', qb, kb) * (dh ** -0.5)
    s = jnp.where(jnp.asarray(valid), s, NEG_INF)
    m = jnp.max(s, axis=-1, keepdims=True)
    p = jnp.exp(s - m)
    l = jnp.sum(p, axis=-1, keepdims=True)
    o = jnp.einsum('bdhnqk,bdhnkc->bdhnqc', p, vb) / l
    lse = (m + jnp.log(l))[..., 0]
    o = o.reshape(b_, dilation, h_, lp, dh)[:, :, :, :length]
    o = o.transpose(0, 3, 1, 2, 4).reshape(b_, s_, h_, dh)
    lse = lse.reshape(b_, dilation, h_, lp)[..., :length].transpose(0, 3, 1, 2).reshape(b_, s_, h_)
    return o, lse


def dilated_attention_mixer(x, norm_g, w_qkv, q_g, k_g, w_out):
    b_, s_, _ = x.shape
    h = rmsnorm(x, norm_g)
    qkv = jnp.einsum('bsd,de->bse', h, w_qkv)
    q, k, v = jnp.split(qkv, 3, axis=-1)
    q = q.reshape(b_, s_, N_HEADS, HEAD_DIM)
    k = k.reshape(b_, s_, N_HEADS, HEAD_DIM)
    v = v.reshape(b_, s_, N_HEADS, HEAD_DIM)
    q = partial_rope(rmsnorm(q, q_g), s_)
    k = partial_rope(rmsnorm(k, k_g), s_)
    outs, lses = [], []
    for gi, (window, dilation) in enumerate(DILATED_PATTERNS):
        sl = slice(gi * HEADS_PER_GROUP, (gi + 1) * HEADS_PER_GROUP)
        o, lse = dilated_window_attention(q[:, :, sl], k[:, :, sl], v[:, :, sl], window, dilation)
        outs.append(o)
        lses.append(lse)
    outs = jnp.stack(outs, axis=2)
    alpha = jax.nn.softmax(jnp.stack(lses, axis=2), axis=2)
    mixed = (outs * alpha[..., None]).reshape(b_, s_, ATTN_WIDTH).astype(x.dtype)
    return jnp.einsum('bse,ed->bsd', mixed, w_out)


def fourier_mixer(x, norm_g, w_in, w_out):
    b_, s_, _ = x.shape
    h = rmsnorm(x, norm_g)
    u = jnp.einsum('bsd,de->bse', h, w_in).astype(jnp.float32)
    u = u.reshape(b_, s_, FOURIER_GROUPS, FOURIER_GROUP_DIM)
    f = jnp.fft.fft2(u, axes=(1, 3), norm='ortho').real
    f = f.reshape(b_, s_, D_MODEL).astype(x.dtype)
    return jnp.einsum('bse,ed->bsd', f, w_out)


def hierarchical_moe(x, norm_g, w_rg, b_rg, w_re, b_re, w_gate, w_up, w_down):
    b_, s_, d_ = x.shape
    n = b_ * s_
    h = rmsnorm(x, norm_g).reshape(n, d_)
    hf = h.astype(jnp.float32)
    coarse = hf @ w_rg.astype(jnp.float32) + b_rg.astype(jnp.float32)
    g_sel = jnp.argmax(coarse, axis=-1)
    g_gate = jnp.take_along_axis(jax.nn.softmax(coarse, axis=-1), g_sel[:, None], axis=-1)
    fine = (hf @ w_re.astype(jnp.float32) + b_re.astype(jnp.float32)).reshape(n, N_EXPERT_GROUPS, EXPERTS_PER_GROUP)
    fine = jnp.take_along_axis(fine, g_sel[:, None, None], axis=1)[:, 0]
    top_v, top_i = lax.top_k(fine, TOP_K_INNER)
    weights = g_gate * jax.nn.softmax(top_v, axis=-1)
    experts = g_sel[:, None] * EXPERTS_PER_GROUP + top_i

    n_assign = n * TOP_K_INNER
    e_flat = experts.reshape(-1).astype(jnp.int32)
    w_flat = weights.reshape(-1)
    tok_flat = jnp.repeat(jnp.arange(n, dtype=jnp.int32), TOP_K_INNER)
    counts = jnp.zeros((N_EXPERTS,), jnp.int32).at[e_flat].add(1)
    padded = ((counts + MOE_BLOCK - 1) // MOE_BLOCK) * MOE_BLOCK
    pend = jnp.cumsum(padded)
    pstart = pend - padded
    start = jnp.cumsum(counts) - counts
    order = jnp.argsort(e_flat, stable=True)
    se = e_flat[order]
    dest = pstart[se] + (jnp.arange(n_assign, dtype=jnp.int32) - start[se])
    n_blocks = -(-n_assign // MOE_BLOCK) + N_EXPERTS
    cap = n_blocks * MOE_BLOCK
    slot_tok = jnp.full((cap,), n, jnp.int32).at[dest].set(tok_flat[order])
    slot_w = jnp.zeros((cap,), jnp.float32).at[dest].set(w_flat[order])
    block_start = jnp.arange(n_blocks, dtype=jnp.int32) * MOE_BLOCK
    block_e = jnp.minimum(jnp.searchsorted(pend, block_start, side='right'), N_EXPERTS - 1)

    h_pad = jnp.concatenate([h, jnp.zeros((1, d_), h.dtype)], axis=0)
    xs = h_pad[slot_tok].reshape(n_blocks, MOE_BLOCK, d_)

    def expert_block(args):
        xb, e = args
        a = jax.nn.silu(xb @ w_gate[e]) * (xb @ w_up[e])
        return a @ w_down[e]

    ys = lax.map(expert_block, (xs, block_e)).reshape(cap, d_)
    ys = ys * slot_w[:, None].astype(ys.dtype)
    out = jnp.zeros((n + 1, d_), ys.dtype).at[slot_tok].add(ys)[:n]
    return out.reshape(b_, s_, d_).astype(x.dtype)


def setup_inputs(seed: int = 0) -> dict:
    key = jax.random.key(seed)
    ks = jax.random.split(key, 20)
    f32 = jnp.float32
    nrm = lambda k, shape, scale: jax.random.normal(k, shape, f32) * scale
    gain = lambda k, shape: 1.0 + 0.02 * jax.random.normal(k, shape, f32)
    return {
        "x": jax.random.normal(ks[0], (BATCH, SEQ, D_MODEL), f32),
        "attn_norm_g": gain(ks[1], (N_ATTN_LAYERS, D_MODEL)),
        "w_qkv": nrm(ks[2], (N_ATTN_LAYERS, D_MODEL, 3 * ATTN_WIDTH), D_MODEL ** -0.5),
        "q_norm_g": gain(ks[3], (N_ATTN_LAYERS, HEAD_DIM)),
        "k_norm_g": gain(ks[4], (N_ATTN_LAYERS, HEAD_DIM)),
        "w_attn_out": nrm(ks[5], (N_ATTN_LAYERS, ATTN_WIDTH, D_MODEL), ATTN_WIDTH ** -0.5),
        "fourier_norm_g": gain(ks[6], (N_FOURIER_LAYERS, D_MODEL)),
        "w_fourier_in": nrm(ks[7], (N_FOURIER_LAYERS, D_MODEL, D_MODEL), D_MODEL ** -0.5),
        "w_fourier_out": nrm(ks[8], (N_FOURIER_LAYERS, D_MODEL, D_MODEL), D_MODEL ** -0.5),
        "moe_norm_g": gain(ks[9], (DEPTH, D_MODEL)),
        "w_router_group": nrm(ks[10], (DEPTH, D_MODEL, N_EXPERT_GROUPS), D_MODEL ** -0.5),
        "b_router_group": nrm(ks[11], (DEPTH, N_EXPERT_GROUPS), 0.01),
        "w_router_expert": nrm(ks[12], (DEPTH, D_MODEL, N_EXPERTS), D_MODEL ** -0.5),
        "b_router_expert": nrm(ks[13], (DEPTH, N_EXPERTS), 0.01),
        "w_expert_gate": nrm(ks[14], (DEPTH, N_EXPERTS, D_MODEL, D_EXPERT), D_MODEL ** -0.5),
        "w_expert_up": nrm(ks[15], (DEPTH, N_EXPERTS, D_MODEL, D_EXPERT), D_MODEL ** -0.5),
        "w_expert_down": nrm(ks[16], (DEPTH, N_EXPERTS, D_EXPERT, D_MODEL), D_EXPERT ** -0.5),
    }


def reference(x, attn_norm_g, w_qkv, q_norm_g, k_norm_g, w_attn_out,
              fourier_norm_g, w_fourier_in, w_fourier_out,
              moe_norm_g, w_router_group, b_router_group, w_router_expert, b_router_expert,
              w_expert_gate, w_expert_up, w_expert_down):
    for i in range(DEPTH):
        j = i // N_MIXERS
        if i % N_MIXERS == 0:
            x = x + dilated_attention_mixer(x, attn_norm_g[j], w_qkv[j], q_norm_g[j], k_norm_g[j], w_attn_out[j])
        else:
            x = x + fourier_mixer(x, fourier_norm_g[j], w_fourier_in[j], w_fourier_out[j])
        x = x + hierarchical_moe(x, moe_norm_g[i], w_router_group[i], b_router_group[i],
                                 w_router_expert[i], b_router_expert[i],
                                 w_expert_gate[i], w_expert_up[i], w_expert_down[i])
    return x
```

```cpp
#include <hip/hip_runtime.h>
#include <cstdio>
#include <cstdint>

#define GAS __attribute__((address_space(1)))
#define LAS __attribute__((address_space(3)))
typedef unsigned short bf16;
typedef float f32x4 __attribute__((ext_vector_type(4)));
typedef unsigned u32x4 __attribute__((ext_vector_type(4)));
typedef unsigned u32x2 __attribute__((ext_vector_type(2)));
typedef short bf16x8 __attribute__((ext_vector_type(8)));
typedef short s16x4 __attribute__((ext_vector_type(4)));

constexpr int BATCH = 8, SEQ = 2048, DM = 2048, NTOK = BATCH * SEQ;
constexpr int NHEAD = 12, HD = 128, AW = 1536, QKVW = 4608;
constexpr int NE = 64, DE = 512, NGRP = 8;
constexpr int FG = 8, FC = 256;
constexpr float EPS = 1e-6f;
constexpr int NWAVES = 8, NTHR = 512;
constexpr int SLOT_CAP = 49152;

constexpr size_t MiB = 1u << 20;
constexpr size_t WS_CTL = 0, CTL_BYTES = 98304;
constexpr size_t WS_WQKVT = 2 * MiB;
constexpr size_t WS_WOT = 22 * MiB;
constexpr size_t WS_WINB = 30 * MiB;
constexpr size_t WS_WPT = 40 * MiB;
constexpr size_t WS_W2T = 50 * MiB;
constexpr size_t WS_HART = 60 * MiB;
constexpr size_t WS_TT = 70 * MiB;
constexpr size_t WS_ROPE = 71 * MiB;
constexpr size_t WS_RTAB = 72 * MiB;
constexpr size_t WS_SLOT = 75 * MiB;
constexpr size_t WS_SLOTW = 76 * MiB;
constexpr size_t WS_LSE = 77 * MiB;
constexpr size_t WS_SSQ = 78 * MiB;
constexpr size_t WS_TOKL = 80 * MiB;
constexpr size_t WS_H = 96 * MiB;
constexpr size_t WS_QKV = 160 * MiB;
constexpr size_t WS_O = 304 * MiB;
constexpr size_t WS_MIX = 352 * MiB;
constexpr size_t WS_XA = 400 * MiB;
constexpr size_t WS_XB = 528 * MiB;
constexpr size_t WS_A = 352 * MiB;
constexpr size_t WS_Y = 160 * MiB;
constexpr size_t WS_VSYM = 160 * MiB;
constexpr size_t WS_Z = 224 * MiB;
constexpr size_t WS_END = 656 * MiB;
constexpr int CW_BAR = 4096;
constexpr int CW_CNT = 16384;
constexpr int CW_DONE = 8192;
constexpr int CW_Q = 22528;
constexpr int CW_RANK = 20480;

#ifndef FASTMASK_V
#define FASTMASK_V 0x1ff
#endif
constexpr int FASTMASK = FASTMASK_V;
#ifndef PROBE_SAMEW
#define PROBE_SAMEW 0
#endif
#ifndef REPMASK
#define REPMASK 0
#endif
constexpr int LDS_BYTES = 147456;
constexpr int MISC_OFF = 139264;

__device__ __forceinline__ float bf2f(bf16 v) { return __uint_as_float(((unsigned)v) << 16); }
__device__ __forceinline__ unsigned f2bf(float f) { unsigned u = __float_as_uint(f); return (u + 0x7fffu + ((u >> 16) & 1u)) >> 16; }
__device__ __forceinline__ unsigned pk2(float lo, float hi) { return f2bf(lo) | (f2bf(hi) << 16); }
template <int O> __device__ __forceinline__ float xshfl(float v) { return __int_as_float(__builtin_amdgcn_ds_swizzle(__float_as_int(v), (O << 10) | 0x1F)); }
__device__ __forceinline__ float half_sum(float v) { const auto r = __builtin_amdgcn_permlane32_swap(__float_as_uint(v), __float_as_uint(v), false, false); return __uint_as_float(r[0]) + __uint_as_float(r[1]); }
__device__ __forceinline__ float half_max(float v) { const auto r = __builtin_amdgcn_permlane32_swap(__float_as_uint(v), __float_as_uint(v), false, false); return fmaxf(__uint_as_float(r[0]), __uint_as_float(r[1])); }
__device__ __forceinline__ float wave_sum(float v) { v += xshfl<1>(v); v += xshfl<2>(v); v += xshfl<4>(v); v += xshfl<8>(v); v += xshfl<16>(v); return half_sum(v); }
__device__ __forceinline__ float wave_max(float v) { v = fmaxf(v, xshfl<1>(v)); v = fmaxf(v, xshfl<2>(v)); v = fmaxf(v, xshfl<4>(v)); v = fmaxf(v, xshfl<8>(v)); v = fmaxf(v, xshfl<16>(v)); return half_max(v); }

#define XB_TMO      128
#define XB_XCNT(j)  (256  + 64 * (j))
#define XB_XSUB(j)  (1280 + 64 * (j))
#define XB_XGEN(j)  (2304 + 64 * (j))
#define XB_TOP      3328
#define XB_TOPGEN   3392
#define XCD_BAR_WORDS 3456
#define XB_SPIN_CAP (1u << 22)

__device__ __forceinline__ unsigned xb_ld(unsigned* p)              { return __hip_atomic_load(p, __ATOMIC_RELAXED, __HIP_MEMORY_SCOPE_AGENT); }
__device__ __forceinline__ unsigned xb_add(unsigned* p, unsigned v) { return __hip_atomic_fetch_add(p, v, __ATOMIC_RELAXED, __HIP_MEMORY_SCOPE_AGENT); }
__device__ __forceinline__ unsigned xb_xcc_id() { return (unsigned)__builtin_amdgcn_s_getreg((3 << 11) | 20) & 0xFu; }
#define XB_SPIN(cond, bar) do { unsigned _sp = 0; while (cond) { __builtin_amdgcn_s_sleep(1); \
    if ((++_sp & 255u) == 0u) { if (xb_ld(&(bar)[XB_TMO])) break; if (_sp > XB_SPIN_CAP) { atomicAdd(&(bar)[XB_TMO], 1u); break; } } } } while (0)

__device__ __forceinline__ void xb_ld16(unsigned* bar, unsigned (&c)[16]) {
    const unsigned* p = bar + XB_XCNT(0);
    asm volatile(
        "global_load_dword %0, %16, off sc1\n\t"              "global_load_dword %1, %16, off offset:256 sc1\n\t"
        "global_load_dword %2, %16, off offset:512 sc1\n\t"   "global_load_dword %3, %16, off offset:768 sc1\n\t"
        "global_load_dword %4, %16, off offset:1024 sc1\n\t"  "global_load_dword %5, %16, off offset:1280 sc1\n\t"
        "global_load_dword %6, %16, off offset:1536 sc1\n\t"  "global_load_dword %7, %16, off offset:1792 sc1\n\t"
        "global_load_dword %8, %16, off offset:2048 sc1\n\t"  "global_load_dword %9, %16, off offset:2304 sc1\n\t"
        "global_load_dword %10, %16, off offset:2560 sc1\n\t" "global_load_dword %11, %16, off offset:2816 sc1\n\t"
        "global_load_dword %12, %16, off offset:3072 sc1\n\t" "global_load_dword %13, %16, off offset:3328 sc1\n\t"
        "global_load_dword %14, %16, off offset:3584 sc1\n\t" "global_load_dword %15, %16, off offset:3840 sc1\n\t"
        "s_waitcnt vmcnt(0)"
        : "=&v"(c[0]), "=&v"(c[1]), "=&v"(c[2]), "=&v"(c[3]), "=&v"(c[4]), "=&v"(c[5]), "=&v"(c[6]), "=&v"(c[7]),
          "=&v"(c[8]), "=&v"(c[9]), "=&v"(c[10]), "=&v"(c[11]), "=&v"(c[12]), "=&v"(c[13]), "=&v"(c[14]), "=&v"(c[15])
        : "v"(p) : "memory");
}
struct XcdBarrier { unsigned* bar; unsigned x; volatile LAS unsigned* st; };

__device__ __forceinline__ XcdBarrier xcd_barrier_post(unsigned* bar, volatile LAS unsigned* st, bool leader) {
    XcdBarrier b; b.bar = bar; b.x = xb_xcc_id(); b.st = st;
    if (leader) (void)xb_add(&bar[XB_XCNT(b.x)], 1u);
    return b;
}
__device__ __forceinline__ void xcd_barrier_complete(unsigned* bar, unsigned x, unsigned& nloc, unsigned& nx) {
    const unsigned G = gridDim.x * gridDim.y * gridDim.z;
    unsigned sum, cnt, mine, sp = 0u;
    for (;;) {
        sum = 0u; cnt = 0u; mine = 0u;
        unsigned c[16]; xb_ld16(bar, c);
#pragma unroll
        for (unsigned j = 0; j < 16; ++j) { sum += c[j]; cnt += (c[j] > 0u) ? 1u : 0u; mine = (j == x) ? c[j] : mine; }
        if (sum == G) break;
        __builtin_amdgcn_s_sleep(1);
        if ((++sp & 255u) == 0u) { if (xb_ld(&bar[XB_TMO])) break; if (sp > XB_SPIN_CAP) { atomicAdd(&bar[XB_TMO], 1u); break; } }
    }
    nloc = mine > 0u ? mine : 1u; nx = cnt > 0u ? cnt : 1u;
}
__device__ __forceinline__ void xcd_barrier(const XcdBarrier& b, bool leader) {
    asm volatile("s_waitcnt vmcnt(0)" ::: "memory");
    __syncthreads();
    if (leader) {
        unsigned* bar = b.bar;
        __builtin_amdgcn_s_waitcnt(0);
        unsigned nloc = b.st[0], nx = b.st[1];
        if (nloc == 0u) { xcd_barrier_complete(bar, b.x, nloc, nx); b.st[0] = nloc; b.st[1] = nx; }
        const unsigned old = xb_add(&bar[XB_XSUB(b.x)], 1u);
        const unsigned gen = old / nloc;
        if (old + 1u == (gen + 1u) * nloc) {
            __builtin_amdgcn_fence(__ATOMIC_RELEASE, "agent");
            asm volatile("s_waitcnt vmcnt(0)" ::: "memory");
            const unsigned og = xb_add(&bar[XB_TOP], 1u);
            const unsigned tg = og / nx;
            if (og + 1u == (tg + 1u) * nx) xb_add(&bar[XB_TOPGEN], 1u);
            else XB_SPIN(xb_ld(&bar[XB_TOPGEN]) == tg, bar);
            __builtin_amdgcn_fence(__ATOMIC_ACQUIRE, "agent");
            xb_add(&bar[XB_XGEN(b.x)], 1u);
            asm volatile("s_waitcnt vmcnt(0)" ::: "memory");
        } else {
            XB_SPIN(xb_ld(&bar[XB_XGEN(b.x)]) == gen, bar);
            __builtin_amdgcn_fence(__ATOMIC_ACQUIRE, "agent");
            asm volatile("s_waitcnt vmcnt(0)" ::: "memory");
        }
    }
    __syncthreads();
}

struct Args { const float* in[17]; float* out; unsigned char* ws; int ph_lo, ph_hi; };

struct Frame {
    LAS unsigned char* lds;
    int tid, lane, wave, G, bid;
    float* out; unsigned char* ws;
};

template <class SF>
__device__ __forceinline__ void transpose_item(SF src4, int N, bf16* dst, int Kd, LAS float* scr, int item, int lane) {
    const int nblk = N / 64, kb = item / nblk, nb = item % nblk, k0 = 64 * kb, n0 = 64 * nb;
    f32x4 v[16];
#pragma unroll
    for (int i = 0; i < 16; ++i) v[i] = src4(k0 + (lane >> 4) + 4 * i, n0 + 4 * (lane & 15));
#pragma unroll
    for (int i = 0; i < 16; ++i) *(LAS f32x4*)(scr + ((lane >> 4) + 4 * i) * 68 + 4 * (lane & 15)) = v[i];
    asm volatile("s_waitcnt lgkmcnt(0)" ::: "memory");
    const int c = lane & 7;
#pragma unroll
    for (int j = 0; j < 8; ++j) { const int n = (lane >> 3) + 8 * j; const LAS float* s = scr + (8 * c) * 68 + n;
        u32x4 o; o.x = pk2(s[0 * 68], s[1 * 68]); o.y = pk2(s[2 * 68], s[3 * 68]); o.z = pk2(s[4 * 68], s[5 * 68]); o.w = pk2(s[6 * 68], s[7 * 68]);
        *(u32x4*)(dst + (size_t)(n0 + n) * Kd + k0 + 8 * c) = o; }
    asm volatile("s_waitcnt lgkmcnt(0)" ::: "memory");
}

__device__ __forceinline__ void rms_row_to_bf16(const float* xrow, const float* g, bf16* orow, int lane) {
    const f32x4* xr = (const f32x4*)xrow + lane; const f32x4* gr = (const f32x4*)g + lane;
    f32x4 v[8]; float s = 0.f;
#pragma unroll
    for (int j = 0; j < 8; ++j) { v[j] = xr[64 * j]; s += (v[j].x * v[j].x + v[j].y * v[j].y) + (v[j].z * v[j].z + v[j].w * v[j].w); }
    const float rstd = 1.0f / sqrtf(wave_sum(s) * (1.f / DM) + EPS);
    u32x2* o8 = (u32x2*)orow + lane;
#pragma unroll
    for (int j = 0; j < 8; ++j) { const f32x4 gg = gr[64 * j]; u32x2 w; w.x = pk2(v[j].x * rstd * gg.x, v[j].y * rstd * gg.y); w.y = pk2(v[j].z * rstd * gg.z, v[j].w * rstd * gg.w); o8[64 * j] = w; }
}

template <bool A_KC, bool B_KC, class AF, class BF>
__device__ __forceinline__ void ngemm_tile(LAS float* sm, int K, AF af, BF bf, float (&acc)[4][8]) {
    LAS float* As = sm; LAS float* Bs = sm + 16 * 132;
    const int tid = threadIdx.x, ty = tid >> 4, tx = tid & 15;
#pragma unroll
    for (int r = 0; r < 4; ++r)
#pragma unroll
        for (int c = 0; c < 8; ++c) acc[r][c] = 0.f;
    for (int k0 = 0; k0 < K; k0 += 16) {
#pragma unroll
        for (int q = 0; q < 4; ++q) {
            const int e = tid + 512 * q;
            { int k, i; if (A_KC) { k = e & 15; i = e >> 4; } else { i = e & 127; k = e >> 7; } As[k * 132 + i] = af(i, k0 + k); }
            { int k, j; if (B_KC) { k = e & 15; j = e >> 4; } else { j = e & 127; k = e >> 7; } Bs[k * 132 + j] = bf(k0 + k, j); }
        }
        __syncthreads();
#pragma unroll 2
        for (int k = 0; k < 16; ++k) {
            float a[4], b[8];
#pragma unroll
            for (int r = 0; r < 4; ++r) a[r] = As[k * 132 + ty * 4 + r];
#pragma unroll
            for (int c = 0; c < 8; ++c) b[c] = Bs[k * 132 + tx * 8 + c];
#pragma unroll
            for (int r = 0; r < 4; ++r)
#pragma unroll
                for (int c = 0; c < 8; ++c) acc[r][c] += a[r] * b[c];
        }
        __syncthreads();
    }
}

typedef float f32x2 __attribute__((ext_vector_type(2)));
typedef __bf16 b16x2 __attribute__((ext_vector_type(2)));
__device__ __forceinline__ f32x4 unpk4(u32x2 v) { return (f32x4){__uint_as_float(v.x << 16), __uint_as_float(v.x & 0xffff0000u), __uint_as_float(v.y << 16), __uint_as_float(v.y & 0xffff0000u)}; }
__device__ __forceinline__ unsigned cvtpk(float a, float b) { f32x2 v = {a, b}; b16x2 r = __builtin_convertvector(v, b16x2); return __builtin_bit_cast(unsigned, r); }
__device__ __forceinline__ int kc_byte(int r, int c) { const int st = (r >> 4) * 2 + (c >> 5), ob = (r & 15) * 64 + (c & 31) * 2; return st * 1024 + (ob ^ (((ob >> 9) & 1) << 5)); }
__device__ __forceinline__ void kc_rc(int b, int& R, int& C) { const int st = b >> 10, sb = b & 1023, swz = sb ^ (((sb >> 9) & 1) << 5); R = (st >> 1) * 16 + (swz >> 6); C = (st & 1) * 32 + ((swz & 63) >> 1); }
__device__ __forceinline__ int kn_addr(int row, int colbyte) { return 544 * row + (colbyte ^ (((row >> 3) & 1) << 7)); }
constexpr int STAGE_BYTES = 32768 + 34816;

struct KcLoader {
    const char* base; unsigned off[4]; u32x4 s[4];
    template <class RO> __device__ __forceinline__ void init(const bf16* base_, RO rowoff, int tid) {
        base = (const char*)base_;
#pragma unroll
        for (int i = 0; i < 4; ++i) { const int R = (tid >> 3) + 64 * i; off[i] = (unsigned)(rowoff(R) + (tid & 7) * 8) * 2u; }
    }
    __device__ __forceinline__ void issue(int kt) {
#pragma unroll
        for (int i = 0; i < 4; ++i) s[i] = *(const u32x4*)(base + (size_t)(off[i] + (unsigned)kt * 128u));
    }
    __device__ __forceinline__ void write(LAS unsigned char* dst, int tid) {
        const int r0 = tid >> 3, c = tid & 7;
#pragma unroll
        for (int i = 0; i < 4; ++i) *(LAS u32x4*)(dst + (r0 + 64 * i) * 128 + ((c ^ (r0 & 7)) << 4)) = s[i];
    }
};
struct KnF32Loader {
    const float* cp; int ldb; f32x4 s[8];
    __device__ __forceinline__ void init(const float* cp_, int ldb_) { cp = cp_; ldb = ldb_; }
    __device__ __forceinline__ void issue(int kt) {
#pragma unroll
        for (int i = 0; i < 8; ++i) s[i] = *(const f32x4*)(cp + (size_t)((kt * 64 + i * 8) * ldb));
    }
    __device__ __forceinline__ void write(LAS unsigned char* dst, int wid, int lane) {
#pragma unroll
        for (int i = 0; i < 8; ++i) { const int row = i * 8 + wid; u32x2 w; w.x = cvtpk(s[i].x, s[i].y); w.y = cvtpk(s[i].z, s[i].w);
            *(LAS u32x2*)(dst + kn_addr(row, 8 * lane)) = w; }
    }
};
struct KnBf16Loader {
    const char* base; unsigned off; int ldb; u32x4 s[4];
    __device__ __forceinline__ void init(const bf16* base_, unsigned off_elems, int ldb_) { base = (const char*)base_; off = off_elems * 2u; ldb = ldb_; }
    __device__ __forceinline__ void issue(int kt) {
#pragma unroll
        for (int i = 0; i < 4; ++i) s[i] = *(const u32x4*)(base + (size_t)(off + (unsigned)((kt * 64 + i * 16) * ldb) * 2u));
    }
    __device__ __forceinline__ void write(LAS unsigned char* dst, int wid, int lane) {
#pragma unroll
        for (int i = 0; i < 4; ++i) { const int row = i * 16 + wid * 2 + (lane >> 5); *(LAS u32x4*)(dst + kn_addr(row, 16 * (lane & 31))) = s[i]; }
    }
};

template <int ROWMAP, bool B_KN, class AL, class BL>
__device__ __forceinline__ void fgemm_unit(LAS unsigned char* lds, AL& al, BL& bl, int nt, f32x4 (&acc)[8][4], int tid) {
    const int wid = __builtin_amdgcn_readfirstlane(tid >> 6), lane = tid & 63, wr = wid >> 2, wc = wid & 3, fr = lane & 15, fq = lane >> 4;
#pragma unroll
    for (int m = 0; m < 8; ++m)
#pragma unroll
        for (int n = 0; n < 4; ++n) acc[m][n] = (f32x4){0.f, 0.f, 0.f, 0.f};
#define BWRITE(p) do { if constexpr (B_KN) bl.write((p), wid, lane); else bl.write((p), tid); } while (0)
    al.issue(0); bl.issue(0);
    al.write(lds, tid); BWRITE(lds + 32768);
    al.issue(1); bl.issue(1);
    __syncthreads();
    const int xk0 = ((fq ^ (fr & 7)) << 4), xk1 = (((4 + fq) ^ (fr & 7)) << 4);
    int aoff[2];
    if (ROWMAP == 0) { aoff[0] = (wr * 128 + fr) * 128; aoff[1] = aoff[0] + 4 * 2048; }
    else { aoff[0] = (wr * 64 + fr) * 128; aoff[1] = (128 + wr * 64 + fr) * 128; }
    const int boff = (wc * 64 + fr) * 128;
    const int g = lane >> 4, q = (lane & 15) >> 2, p = lane & 3;
    const int troff = (8 * g + q) * 544 + ((wc * 128 + 8 * p) ^ ((g & 1) << 7));
#pragma unroll 1
    for (int t = 0; t < nt; ++t) {
        const int cur = t & 1;
        LAS unsigned char* SA = lds + cur * STAGE_BYTES; LAS unsigned char* SBp = SA + 32768;
        if (t + 1 < nt) { al.write(lds + (cur ^ 1) * STAGE_BYTES, tid); BWRITE(lds + (cur ^ 1) * STAGE_BYTES + 32768); }
        if (t + 2 < nt) { al.issue(t + 2); bl.issue(t + 2); }
        __builtin_amdgcn_sched_barrier(0);
#pragma unroll
        for (int ks = 0; ks < 2; ++ks) {
            bf16x8 At[8], Bf[4];
#pragma unroll
            for (int m = 0; m < 8; ++m) At[m] = *(const LAS bf16x8*)(SA + aoff[m >> 2] + (m & 3) * 2048 + (ks ? xk1 : xk0));
            if (!B_KN) {
#pragma unroll
                for (int n = 0; n < 4; ++n) Bf[n] = *(const LAS bf16x8*)(SBp + boff + n * 2048 + (ks ? xk1 : xk0));
            } else {
#pragma unroll
                for (int n = 0; n < 4; ++n) {
                    s16x4 h[2];
#pragma unroll
                    for (int tt = 0; tt < 2; ++tt) h[tt] = __builtin_amdgcn_ds_read_tr16_b64_v4i16((LAS s16x4*)(SBp + troff + n * 32 + (32 * ks + 4 * tt) * 544));
                    Bf[n] = __builtin_shufflevector(h[0], h[1], 0, 1, 2, 3, 4, 5, 6, 7);
                }
            }
#pragma unroll
            for (int m = 0; m < 8; ++m)
#pragma unroll
                for (int n = 0; n < 4; ++n) acc[m][n] = __builtin_amdgcn_mfma_f32_16x16x32_bf16(Bf[n], At[m], acc[m][n], 0, 0, 0);
            __builtin_amdgcn_sched_barrier(0);
        }
        __syncthreads();
    }
}

struct GldsKc { static constexpr int AMODE = 0;
    const char* base; unsigned off[4];
    template <class RO> __device__ __forceinline__ void init(const bf16* base_, RO rowoff, int tid) {
        base = (const char*)base_;
#pragma unroll
        for (int i = 0; i < 4; ++i) { const int R = (tid >> 3) + 64 * i; off[i] = (unsigned)(rowoff(R) + (((tid & 7) ^ ((tid >> 3) & 7)) * 8)) * 2u; }
    }
    template <class RO> __device__ __forceinline__ void init_i(const bf16* base_, RO rowoff, int tid) {
        base = (const char*)base_;
#pragma unroll
        for (int i = 0; i < 4; ++i) { const int R = (tid >> 3) + 64 * i; off[i] = (unsigned)(rowoff(R, i) + (((tid & 7) ^ ((tid >> 3) & 7)) * 8)) * 2u; }
    }
    __device__ __forceinline__ void stage(LAS unsigned char* dst, int kt, int wid) {
#pragma unroll
        for (int i = 0; i < 4; ++i) __builtin_amdgcn_global_load_lds((const unsigned*)(base + (size_t)(off[i] + (unsigned)kt * 128u)), (LAS unsigned*)(dst + wid * 1024 + i * 8192), 16, 0, 0);
    }
};
struct MixA { static constexpr int AMODE = 1;
    const char* ob; const float* lse; unsigned off[4], lo[4]; u32x4 s[4]; float l[4][3], av[4]; int gsel;
    __device__ __forceinline__ void init(const bf16* O_, const float* lse_, int row0, int tid) { ob = (const char*)O_; lse = lse_; gsel = 0;
#pragma unroll
        for (int i = 0; i < 4; ++i) { const int R = row0 + (tid >> 3) + 64 * i; off[i] = (unsigned)(R * AW + (((tid & 7) ^ ((tid >> 3) & 7)) * 8)) * 2u; lo[i] = (unsigned)(R * NHEAD) * 4u; } }
    __device__ __forceinline__ void issue(int kt) {
#pragma unroll
        for (int i = 0; i < 4; ++i) s[i] = *(const u32x4*)(ob + (size_t)(off[i] + (unsigned)kt * 128u));
        if ((kt & 1) == 0) { const int h = kt >> 1, hg = h & 3; gsel = h >> 2;
#pragma unroll
            for (int i = 0; i < 4; ++i) { const float* p = (const float*)((const char*)lse + lo[i]) + hg; l[i][0] = p[0]; l[i][1] = p[4]; l[i][2] = p[8]; } }
    }
    __device__ __forceinline__ void write(LAS unsigned char* dst, int tid, int kt) {
        if ((kt & 1) == 0) {
#pragma unroll
            for (int i = 0; i < 4; ++i) { const float m = fmaxf(l[i][0], fmaxf(l[i][1], l[i][2])); const float e0 = __expf(l[i][0] - m), e1 = __expf(l[i][1] - m), e2 = __expf(l[i][2] - m);
                av[i] = (gsel == 0 ? e0 : (gsel == 1 ? e1 : e2)) / (e0 + e1 + e2); } }
#pragma unroll
        for (int i = 0; i < 4; ++i) { const float a = av[i]; const u32x4 v = s[i]; u32x4 o;
            o.x = cvtpk(__uint_as_float(v.x << 16) * a, __uint_as_float(v.x & 0xffff0000u) * a); o.y = cvtpk(__uint_as_float(v.y << 16) * a, __uint_as_float(v.y & 0xffff0000u) * a);
            o.z = cvtpk(__uint_as_float(v.z << 16) * a, __uint_as_float(v.z & 0xffff0000u) * a); o.w = cvtpk(__uint_as_float(v.w << 16) * a, __uint_as_float(v.w & 0xffff0000u) * a);
            *(LAS u32x4*)(dst + tid * 16 + i * 8192) = o; }
    }
};
template <int ROWMAP, int BMODE, class BL, class AL>
__device__ __forceinline__ void fgemm2(LAS unsigned char* lds, AL& al, BL& bl, int nt, f32x4 (&acc)[8][4], int tid) {
    const int wid = __builtin_amdgcn_readfirstlane(tid >> 6), lane = tid & 63, wr = wid >> 2, wc = wid & 3, fr = lane & 15, fq = lane >> 4;
#pragma unroll
    for (int m = 0; m < 8; ++m)
#pragma unroll
        for (int n = 0; n < 4; ++n) acc[m][n] = (f32x4){0.f, 0.f, 0.f, 0.f};
    if constexpr (AL::AMODE == 0) al.stage(lds, 0, wid); else { al.issue(0); al.write(lds, tid, 0); if (nt > 1) al.issue(1); }
    if constexpr (BMODE == 0) bl.stage(lds + 32768, 0, wid);
    else { bl.issue(0); bl.write(lds + 32768, wid, lane); if (nt > 1) bl.issue(1); }
    asm volatile("s_waitcnt vmcnt(0)" ::: "memory");
    __syncthreads();
    const int xk0 = ((fq ^ (fr & 7)) << 4), xk1 = (((4 + fq) ^ (fr & 7)) << 4);
    int aoff[2];
    if (ROWMAP == 0) { aoff[0] = (wr * 128 + fr) * 128; aoff[1] = aoff[0] + 4 * 2048; }
    else { aoff[0] = (wr * 64 + fr) * 128; aoff[1] = (128 + wr * 64 + fr) * 128; }
    const int boff = (wc * 64 + fr) * 128;
    const int g = lane >> 4, q = (lane & 15) >> 2, p = lane & 3;
    const int troff = (8 * g + q) * 544 + ((wc * 128 + 8 * p) ^ ((g & 1) << 7));
#define DSR128(dst, addr, off) asm volatile("ds_read_b128 %0, %1 offset:%2" : "=v"(dst) : "v"(addr), "n"(off) : "memory")
#define DSRTR(dst, addr, off) asm volatile("ds_read_b64_tr_b16 %0, %1 offset:%2" : "=v"(dst) : "v"(addr), "n"(off) : "memory")
#define LGKM(n) do { asm volatile("s_waitcnt lgkmcnt(%0)" :: "n"(n) : "memory"); __builtin_amdgcn_sched_barrier(0); } while (0)
#define F2_LDB4(Bv, Bh0, Bh1, ks) do { if constexpr (BMODE == 0) { DSR128(Bv[0], (ks) ? bb1 : bb0, 0); DSR128(Bv[1], (ks) ? bb1 : bb0, 2048); DSR128(Bv[2], (ks) ? bb1 : bb0, 4096); DSR128(Bv[3], (ks) ? bb1 : bb0, 6144); } \
        else { DSRTR(Bh0[0], bt, 0 + (32 * (ks)) * 544); DSRTR(Bh1[0], bt, 0 + (32 * (ks) + 4) * 544); DSRTR(Bh0[1], bt, 32 + (32 * (ks)) * 544); DSRTR(Bh1[1], bt, 32 + (32 * (ks) + 4) * 544); \
               DSRTR(Bh0[2], bt, 64 + (32 * (ks)) * 544); DSRTR(Bh1[2], bt, 64 + (32 * (ks) + 4) * 544); DSRTR(Bh0[3], bt, 96 + (32 * (ks)) * 544); DSRTR(Bh1[3], bt, 96 + (32 * (ks) + 4) * 544); } } while (0)
#define F2_BFRAG(Bv, Bh0, Bh1, n) (BMODE == 0 ? Bv[n] : __builtin_shufflevector(Bh0[n], Bh1[n], 0, 1, 2, 3, 4, 5, 6, 7))
#define F2_MMA8(mA, Aa, Ab, Bv, Bh0, Bh1) do { _Pragma("unroll") for (int n = 0; n < 4; ++n) acc[mA][n] = __builtin_amdgcn_mfma_f32_16x16x32_bf16(F2_BFRAG(Bv, Bh0, Bh1, n), Aa, acc[mA][n], 0, 0, 0); \
        _Pragma("unroll") for (int n = 0; n < 4; ++n) acc[mA + 1][n] = __builtin_amdgcn_mfma_f32_16x16x32_bf16(F2_BFRAG(Bv, Bh0, Bh1, n), Ab, acc[mA + 1][n], 0, 0, 0); } while (0)
    constexpr int NB = (BMODE == 0) ? 4 : 8;
    bf16x8 Bc[4], Bn[4]; s16x4 Bc0[4], Bc1[4], Bn0[4], Bn1[4]; bf16x8 A0, A1, A2, A3;
    (void)Bc; (void)Bn; (void)Bc0; (void)Bc1; (void)Bn0; (void)Bn1;
    const unsigned sa0 = (unsigned)(size_t)lds;
#define F2_PRODUCE(tt) do { LAS unsigned char* st_ = lds + ((tt) & 1) * STAGE_BYTES; \
        if constexpr (BMODE != 0) bl.write(st_ + 32768, wid, lane); \
        if constexpr (AL::AMODE == 0) al.stage(st_, (tt), wid); else { al.write(st_, tid, (tt)); if ((tt) + 1 < nt) al.issue((tt) + 1); } \
        if constexpr (BMODE == 0) bl.stage(st_ + 32768, (tt), wid); \
        if constexpr (BMODE != 0) { if ((tt) + 1 < nt) bl.issue((tt) + 1); } } while (0)
#define F2_FIRST(cur_) do { const unsigned sa_ = sa0 + (cur_) * STAGE_BYTES; const unsigned bb0_ = sa_ + 32768 + boff + xk0, bt_ = sa_ + 32768 + troff; (void)bb0_; (void)bt_; \
        if constexpr (BMODE == 0) { DSR128(Bc[0], bb0_, 0); DSR128(Bc[1], bb0_, 2048); DSR128(Bc[2], bb0_, 4096); DSR128(Bc[3], bb0_, 6144); } \
        else { DSRTR(Bc0[0], bt_, 0); DSRTR(Bc1[0], bt_, 4 * 544); DSRTR(Bc0[1], bt_, 32); DSRTR(Bc1[1], bt_, 32 + 4 * 544); DSRTR(Bc0[2], bt_, 64); DSRTR(Bc1[2], bt_, 64 + 4 * 544); DSRTR(Bc0[3], bt_, 96); DSRTR(Bc1[3], bt_, 96 + 4 * 544); } \
        DSR128(A0, sa_ + aoff[0] + xk0, 0); DSR128(A1, sa_ + aoff[0] + xk0, 2048); } while (0)
    if (nt > 1) F2_PRODUCE(1);
    __builtin_amdgcn_sched_barrier(0);
    F2_FIRST(0);
#pragma unroll 1
    for (int t = 0; t < nt; ++t) {
        const int cur = t & 1;
        const unsigned sa = sa0 + cur * STAGE_BYTES, sb = sa + 32768;
        const unsigned a00 = sa + aoff[0] + xk0, a01 = sa + aoff[0] + xk1, a10 = sa + aoff[1] + xk0, a11 = sa + aoff[1] + xk1;
        const unsigned bb1 = sb + boff + xk1, bt = sb + troff; (void)bb1; (void)bt;
        DSR128(A2, a00, 4096); DSR128(A3, a00, 6144); LGKM(2); F2_MMA8(0, A0, A1, Bc, Bc0, Bc1);
        DSR128(A0, a10, 0); DSR128(A1, a10, 2048); LGKM(2); F2_MMA8(2, A2, A3, Bc, Bc0, Bc1);
        DSR128(A2, a10, 4096); DSR128(A3, a10, 6144); LGKM(2); F2_MMA8(4, A0, A1, Bc, Bc0, Bc1);
        if constexpr (BMODE == 0) { DSR128(Bn[0], bb1, 0); DSR128(Bn[1], bb1, 2048); DSR128(Bn[2], bb1, 4096); DSR128(Bn[3], bb1, 6144); }
        else { DSRTR(Bn0[0], bt, 32 * 544); DSRTR(Bn1[0], bt, 36 * 544); DSRTR(Bn0[1], bt, 32 + 32 * 544); DSRTR(Bn1[1], bt, 32 + 36 * 544); DSRTR(Bn0[2], bt, 64 + 32 * 544); DSRTR(Bn1[2], bt, 64 + 36 * 544); DSRTR(Bn0[3], bt, 96 + 32 * 544); DSRTR(Bn1[3], bt, 96 + 36 * 544); }
        DSR128(A0, a01, 0); DSR128(A1, a01, 2048); LGKM(NB + 2); F2_MMA8(6, A2, A3, Bc, Bc0, Bc1);
        DSR128(A2, a01, 4096); DSR128(A3, a01, 6144); LGKM(2); F2_MMA8(0, A0, A1, Bn, Bn0, Bn1);
        DSR128(A0, a11, 0); DSR128(A1, a11, 2048); LGKM(2); F2_MMA8(2, A2, A3, Bn, Bn0, Bn1);
        DSR128(A2, a11, 4096); DSR128(A3, a11, 6144); LGKM(2); F2_MMA8(4, A0, A1, Bn, Bn0, Bn1);
        LGKM(0);
        if (t + 1 < nt) {
            asm volatile("s_waitcnt vmcnt(0)" ::: "memory");
            __syncthreads();
            if (t + 2 < nt) F2_PRODUCE(t + 2);
            __builtin_amdgcn_sched_barrier(0);
            F2_FIRST(cur ^ 1);
        }
        F2_MMA8(6, A2, A3, Bn, Bn0, Bn1);
    }
    __syncthreads();
#undef F2_PRODUCE
#undef F2_FIRST
#undef DSR128
#undef DSRTR
#undef LGKM
#undef F2_LDB4
#undef F2_BFRAG
#undef F2_MMA8
}


struct MoeTab { int cnt[NE]; int offs[NE]; };
__device__ __forceinline__ void moe_load_tab(LAS int* tab  , const unsigned* cnt_g, int tid) {
    if (tid < NE) tab[tid] = (int)cnt_g[tid];
    __syncthreads();
    if (tid == 0) { int o = 0; for (int e = 0; e < NE; ++e) { tab[NE + e] = o; o += ((tab[e] + 255) >> 8) << 8; } }
    __syncthreads();
}

__global__ void __launch_bounds__(NTHR, 2) mega(Args args) {
    extern __shared__ __attribute__((aligned(16))) unsigned char lds_raw[];
    Frame F;
    F.lds = (LAS unsigned char*)lds_raw;
    const int wave_s = __builtin_amdgcn_readfirstlane((int)threadIdx.x >> 6);
#define MY_TID() ({ unsigned z_ = 0u; asm volatile("" : "+v"(z_)); wave_s * 64 + (int)__builtin_amdgcn_mbcnt_hi(~0u, __builtin_amdgcn_mbcnt_lo(~0u, z_)); })
    F.tid = MY_TID(); F.lane = F.tid & 63; F.wave = wave_s;
    F.G = gridDim.x; F.bid = blockIdx.x;
    F.out = args.out; F.ws = args.ws;
    volatile LAS unsigned* MISC = (volatile LAS unsigned*)(F.lds + MISC_OFF);
    if (F.tid < 64) MISC[F.tid] = 0u;
    __syncthreads();
    unsigned* ctl = (unsigned*)(F.ws + WS_CTL);
    XcdBarrier bar = xcd_barrier_post(ctl + CW_BAR, MISC + 8, F.tid == 0);
    if (F.tid == 0) MISC[16] = xb_add(ctl + CW_RANK + 64 * bar.x, 1u);
    const int lo = args.ph_lo, hi = args.ph_hi;
#define IN(k) (lo <= (k) && (k) < hi)
#define SEAM(k) do { if (IN(k) && IN((k) + 1)) { int t0_ = MY_TID(); asm volatile("" : "+v"(t0_)); xcd_barrier(bar, t0_ == 0); } } while (0)
#define EPI_IDS() int tz_ = MY_TID(); asm volatile("" : "+v"(tz_)); const int wr = (tz_ >> 8) & 1, wc = (tz_ >> 6) & 3, fr = tz_ & 15, fq = (tz_ >> 4) & 3; (void)wr; (void)wc; (void)fr; (void)fq;
#define PHASE_IDS() int tid_ = MY_TID(); asm volatile("" : "+v"(tid_)); const int PT = tid_, PL = tid_ & 63, PW = ({ int w_ = wave_s; asm volatile("" : "+s"(w_)); w_; }); \
    const int gw = F.bid * NWAVES + PW, NGW = F.G * NWAVES, gt = F.bid * NTHR + PT, NGT = F.G * NTHR; (void)gw; (void)NGW; (void)gt; (void)NGT; (void)PL;

    unsigned char* ws = F.ws;
    bf16* WqkvT = (bf16*)(ws + WS_WQKVT); bf16* WoT = (bf16*)(ws + WS_WOT); bf16* WinB = (bf16*)(ws + WS_WINB);
    bf16* WpT = (bf16*)(ws + WS_WPT); bf16* W2T = (bf16*)(ws + WS_W2T); bf16* HART = (bf16*)(ws + WS_HART); bf16* TT = (bf16*)(ws + WS_TT);
    float* ROPE = (float*)(ws + WS_ROPE);
    bf16* Hb = (bf16*)(ws + WS_H); bf16* QKV = (bf16*)(ws + WS_QKV); bf16* Ob = (bf16*)(ws + WS_O); bf16* MIXb = (bf16*)(ws + WS_MIX);
    float* LSE = (float*)(ws + WS_LSE); float* XA = (float*)(ws + WS_XA); float* XB = (float*)(ws + WS_XB);
    bf16* XAh = (bf16*)(ws + WS_XA); bf16* XBh = (bf16*)(ws + WS_XB);
    bf16* Ab = (bf16*)(ws + WS_A); bf16* Yb = (bf16*)(ws + WS_Y); bf16* VSYM = (bf16*)(ws + WS_VSYM); bf16* Zb = (bf16*)(ws + WS_Z);
    int* TOKL = (int*)(ws + WS_TOKL); int* SLOT = (int*)(ws + WS_SLOT); float* SLOTW = (float*)(ws + WS_SLOTW);
    unsigned* CNT = ctl + CW_CNT;
    float* SSQ = (float*)(ws + WS_SSQ);
    float* RS0 = (float*)(ws + WS_LSE + 983040);
    float* RS2 = (float*)(ws + WS_LSE + 917504);


    if (IN(0)) {
        PHASE_IDS();
#pragma unroll 1
        for (int rep_ = 0; rep_ <= ((REPMASK >> 0) & 1); ++rep_) {
        LAS float* scr = (LAS float*)(F.lds + PW * 17408);
        const float* w_qkv = args.in[2]; const float* w_ao = args.in[5]; const float* w_fo = args.in[8];
        constexpr int I_QKV = (DM / 64) * (QKVW / 64), I_AO = (AW / 64) * (DM / 64), I_W2 = (DM / 64) * (DM / 64);
        {
            const float* xin0 = args.in[0]; const f32x4* gr = (const f32x4*)args.in[1] + PL; f32x4 gg[8];
#pragma unroll
            for (int j = 0; j < 8; ++j) gg[j] = gr[64 * j];
            for (int m0 = gw * 4; m0 < NTOK; m0 += NGW * 4) {
                f32x4 v[4][8];
#pragma unroll
                for (int r = 0; r < 4; ++r) { const f32x4* xr = (const f32x4*)(xin0 + (size_t)(m0 + r) * DM) + PL;
#pragma unroll
                    for (int j = 0; j < 8; ++j) v[r][j] = xr[64 * j]; }
#pragma unroll
                for (int r = 0; r < 4; ++r) { float sq = 0.f;
#pragma unroll
                    for (int j = 0; j < 8; ++j) sq += (v[r][j].x * v[r][j].x + v[r][j].y * v[r][j].y) + (v[r][j].z * v[r][j].z + v[r][j].w * v[r][j].w);
                    const float rstd = 1.0f / sqrtf(wave_sum(sq) * (1.f / DM) + EPS); if (PL == 0) RS0[m0 + r] = rstd;
                    u32x2* o8 = (u32x2*)(Hb + (size_t)(m0 + r) * DM) + PL;
#pragma unroll
                    for (int j = 0; j < 8; ++j) { u32x2 w; w.x = cvtpk(v[r][j].x, v[r][j].y); w.y = cvtpk(v[r][j].z, v[r][j].w); o8[64 * j] = w; } }
            }
        }
        for (int it = gw; it < I_QKV; it += NGW)
            transpose_item([&](int k, int n) { return *(const f32x4*)(w_qkv + (size_t)k * QKVW + n) * args.in[1][k]; }, QKVW, WqkvT, DM, scr, it, PL);
        { const float* w_fi = args.in[7];
          for (int i0 = gt; i0 < DM * DM / 4; i0 += 8 * NGT) { f32x4 v[8];
#pragma unroll
              for (int q = 0; q < 8; ++q) { const int i = i0 + q * NGT; if (i < DM * DM / 4) v[q] = ((const f32x4*)w_fi)[i]; }
#pragma unroll
              for (int q = 0; q < 8; ++q) { const int i = i0 + q * NGT; if (i < DM * DM / 4) { const float gd = args.in[6][i / (DM / 4)];
                  u32x2 o; o.x = cvtpk(v[q].x * gd, v[q].y * gd); o.y = cvtpk(v[q].z * gd, v[q].w * gd); ((u32x2*)WinB)[i] = o; } } } }
        for (int i = gt; i < 256 * 256; i += NGT) { const int j = i >> 8, c = i & 255; float v;
            if (j <= 128) v = cospif((float)((c * j) & 255) * (1.0f / 128.0f)); else v = sinpif((float)((c * (j - 128)) & 255) * (1.0f / 128.0f));
            TT[i] = (bf16)f2bf(v * (0.5f / 16.0f)); }
        for (int i = gt; i < SEQ * 16; i += NGT) { const int pos = i >> 4, fi = i & 15; const float invf = powf(500000.0f, -(float)fi * (1.0f / 16.0f)); const float ang = (float)pos * invf;
            ROPE[2 * i] = cosf(ang); ROPE[2 * i + 1] = sinf(ang); }
    }
}
    SEAM(0);
    { int t0_ = MY_TID(); asm volatile("" : "+v"(t0_));
      if (t0_ == 0) { unsigned pre = 0u, c[16]; xb_ld16(ctl + CW_BAR, c);
#pragma unroll
          for (unsigned j = 0; j < 16; ++j) pre += (j < bar.x) ? c[j] : 0u;
          MISC[17] = (lo == 0 && hi > 1) ? (pre + MISC[16]) : (unsigned)F.bid; }
      __syncthreads(); }
    const int vcu = (int)MISC[17];

    if (IN(1)) {
        PHASE_IDS();
#pragma unroll 1
        for (int rep_ = 0; rep_ <= ((REPMASK >> 1) & 1); ++rep_) {
      if constexpr (FASTMASK & 1) {
        const int wid = PW, lane = PL;
        constexpr int NCT = QKVW / 256, NU = (NTOK / 256) * NCT;
        for (int u = vcu; u < NU; u += F.G) {
            const int pm = u / NCT, pn = u % NCT;
            GldsKc al, bl;
            al.init(Hb, [&](int R) { return (pm * 256 + R) * DM; }, PT);
            bl.init(WqkvT, [&](int R) { return (pn * 256 + R) * DM; }, PT);
            f32x4 acc[8][4];
            fgemm2<0, 0>(F.lds, al, bl, DM / 64, acc, PT);
                    EPI_IDS();
            { float rs8[8];
#pragma unroll
              for (int m = 0; m < 8; ++m) rs8[m] = RS0[pm * 256 + wr * 128 + m * 16 + fr];
#pragma unroll
              for (int m = 0; m < 8; ++m)
#pragma unroll
                  for (int n = 0; n < 4; ++n) acc[m][n] = acc[m][n] * rs8[m]; }
            if (pn < 12) {
                LAS float* SS = (LAS float*)(F.lds + MISC_OFF + 2048);
#pragma unroll
                for (int m = 0; m < 8; ++m) { float ss = 0.f;
#pragma unroll
                    for (int n = 0; n < 4; ++n) ss += (acc[m][n][0] * acc[m][n][0] + acc[m][n][1] * acc[m][n][1]) + (acc[m][n][2] * acc[m][n][2] + acc[m][n][3] * acc[m][n][3]);
                    ss += xshfl<16>(ss); ss = half_sum(ss);
                    if (fq == 0) SS[(wr * 128 + m * 16 + fr) * 4 + wc] = ss; }
                __syncthreads();
                const float* gn = (pn < 6 ? args.in[3] : args.in[4]) + (wc & 1) * 64 + 4 * fq;
                f32x4 gv[4];
#pragma unroll
                for (int n = 0; n < 4; ++n) gv[n] = *(const f32x4*)(gn + n * 16);
#pragma unroll
                for (int mh = 0; mh < 2; ++mh) {
                    f32x4 rp0[4], rp1[4];
#pragma unroll
                    for (int m4 = 0; m4 < 4; ++m4) { const int pos = (pm * 256 + wr * 128 + (mh * 4 + m4) * 16 + fr) & (SEQ - 1);
                        rp0[m4] = *(const f32x4*)(ROPE + (pos * 16 + 4 * fq) * 2); rp1[m4] = *(const f32x4*)(ROPE + (pos * 16 + 4 * fq) * 2 + 4); }
#pragma unroll
                    for (int m4 = 0; m4 < 4; ++m4) { const int m = mh * 4 + m4; const int row = wr * 128 + m * 16 + fr; const float tot = SS[row * 4 + wc] + SS[row * 4 + (wc ^ 1)];
                        const float rstd = 1.0f / sqrtf(tot * (1.f / 128.f) + EPS);
#pragma unroll
                        for (int n = 0; n < 4; ++n) acc[m][n] = acc[m][n] * rstd * gv[n];
                        { const bool ev = (wc & 1) == 0; const f32x4 r0 = rp0[m4], r1 = rp1[m4];
                            const float cs[4] = {ev ? r0.x : 1.f, ev ? r0.z : 1.f, ev ? r1.x : 1.f, ev ? r1.z : 1.f}, sn[4] = {ev ? r0.y : 0.f, ev ? r0.w : 0.f, ev ? r1.y : 0.f, ev ? r1.w : 0.f};
#pragma unroll
                            for (int j = 0; j < 4; ++j) { const float t1 = acc[m][0][j], t2 = acc[m][1][j]; acc[m][0][j] = t1 * cs[j] - t2 * sn[j]; acc[m][1][j] = t2 * cs[j] + t1 * sn[j]; } } }
                }
            }
#pragma unroll
            for (int m = 0; m < 8; ++m) { bf16* o = QKV + (size_t)(pm * 256 + wr * 128 + m * 16 + fr) * QKVW + pn * 256 + wc * 64 + 4 * fq;
#pragma unroll
                for (int n = 0; n < 4; ++n) { u32x2 w; w.x = cvtpk(acc[m][n][0], acc[m][n][1]); w.y = cvtpk(acc[m][n][2], acc[m][n][3]); *(u32x2*)(o + n * 16) = w; } }
        }
        for (int u = (vcu + 128) % F.G; u < 64; u += F.G) {
            const int g = u >> 3, pn = u & 7;
            GldsKc al, bl;
            al.init(TT, [&](int R) { return R * 256; }, PT);
            bl.init(WinB, [&](int R) { return (pn * 256 + R) * DM + g * 256; }, PT);
            f32x4 acc[8][4];
            fgemm2<0, 0>(F.lds, al, bl, 4, acc, PT);
                    EPI_IDS();
#pragma unroll
            for (int m = 0; m < 8; ++m) { bf16* o = WpT + (size_t)(g * 256 + wr * 128 + m * 16 + fr) * DM + pn * 256 + wc * 64 + 4 * fq;
#pragma unroll
                for (int n = 0; n < 4; ++n) { u32x2 w; w.x = cvtpk(acc[m][n][0], acc[m][n][1]); w.y = cvtpk(acc[m][n][2], acc[m][n][3]); *(u32x2*)(o + n * 16) = w; } }
        }
        { const int t0 = (NU % F.G) ? (NU % F.G) : 0;
          if (vcu >= t0) {
            const int gwt = (vcu - t0) * NWAVES + PW, ngwt = (F.G - t0) * NWAVES, gtt = (vcu - t0) * NTHR + PT, ngtt = (F.G - t0) * NTHR;
            LAS float* scr = (LAS float*)(F.lds + PW * 17408);
            const float* w_ao = args.in[5]; const float* w_fo = args.in[8];
            constexpr int I_AO = (AW / 64) * (DM / 64), I_W2 = (DM / 64) * (DM / 64);
            for (int it = gwt; it < I_AO + I_W2; it += ngwt) {
                int r = it;
                if (r < I_AO) { transpose_item([&](int k, int n) { return *(const f32x4*)(w_ao + (size_t)k * DM + n); }, DM, WoT, AW, scr, r, PL); continue; } r -= I_AO;
                transpose_item([&](int k, int n) {
                    const int g = k >> 8, jj = k & 255; const float* w = w_fo + (size_t)(g * 256) * DM + n;
                    const bool single = (jj & 127) == 0; const int ja = jj <= 128 ? jj : 384 - jj, jb = single ? ja : (jj < 128 ? 256 - jj : jj - 128);
                    const float sg = single ? 0.f : (jj < 128 ? 1.f : -1.f);
                    const f32x4 a = *(const f32x4*)(w + (size_t)ja * DM), b = *(const f32x4*)(w + (size_t)jb * DM);
                    return a + b * sg; }, DM, W2T, DM, scr, r, PL);
            }
            for (int i = gtt; i < SEQ * SEQ; i += ngtt) { const int k1 = i >> 11, s = i & 2047; const float a = (float)((k1 * s) & 2047) * (1.0f / 1024.0f);
                HART[i] = (bf16)f2bf((cospif(a) + sinpif(a)) * 0.02209708691207961f); }
            { bf16* RT = (bf16*)(ws + WS_RTAB);
              for (int i = gtt; i < 2 * 80 * DM; i += ngtt) { const int layer = i / (80 * DM), r = i % (80 * DM), n = r / DM, k = r % DM; float w = 0.f;
                  if (n < 8) w = args.in[10][(size_t)layer * DM * 8 + k * 8 + n]; else if (n < 72) w = args.in[12][(size_t)layer * DM * 64 + k * 64 + (n - 8)];
                  const unsigned hi = f2bf(w); const float lo = w - bf2f((bf16)hi);
                  const int d = (((k >> 5) * 5 + (n >> 4)) * 64 + ((k >> 3) & 3) * 16 + (n & 15)) * 8 + (k & 7);
                  RT[(size_t)(layer * 2 + 0) * 80 * DM + d] = (bf16)hi; RT[(size_t)(layer * 2 + 1) * 80 * DM + d] = (bf16)f2bf(lo); } }
          } }
      } else {
        LAS float* sm = (LAS float*)F.lds;
        const int ty = PT >> 4, tx = PT & 15;
        const int NU = (NTOK / 128) * (QKVW / 128);
        for (int u = F.bid; u < NU; u += F.G) {
            const int pm = u / (QKVW / 128), pn = u % (QKVW / 128);
            float acc[4][8];
            const bf16* Ap = Hb + (size_t)pm * 128 * DM; const bf16* Bp = WqkvT + (size_t)pn * 128 * DM;
            ngemm_tile<true, true>(sm, DM, [&](int i, int k) { return bf2f(Ap[(size_t)i * DM + k]); }, [&](int k, int j) { return bf2f(Bp[(size_t)j * DM + k]); }, acc);
#pragma unroll
            for (int r = 0; r < 4; ++r) { bf16* o = QKV + (size_t)(pm * 128 + ty * 4 + r) * QKVW + pn * 128 + tx * 8;
                u32x4 w; w.x = pk2(acc[r][0], acc[r][1]); w.y = pk2(acc[r][2], acc[r][3]); w.z = pk2(acc[r][4], acc[r][5]); w.w = pk2(acc[r][6], acc[r][7]); *(u32x4*)o = w; }
        }
        const int NF = 16 * 16;
        for (int u = F.bid; u < NF; u += F.G) {
            const int pm = u / 16, pn = u % 16;
            const int g = pm >> 1, j0 = (pm & 1) * 128;
            float acc[4][8];
            ngemm_tile<true, true>(sm, 256, [&](int i, int k) { return bf2f(TT[(j0 + i) * 256 + k]); }, [&](int k, int j) { return bf2f(WinB[(size_t)(pn * 128 + j) * DM + g * 256 + k]); }, acc);
#pragma unroll
            for (int r = 0; r < 4; ++r) { bf16* o = WpT + (size_t)(pm * 128 + ty * 4 + r) * DM + pn * 128 + tx * 8;
                u32x4 w; w.x = pk2(acc[r][0], acc[r][1]); w.y = pk2(acc[r][2], acc[r][3]); w.z = pk2(acc[r][4], acc[r][5]); w.w = pk2(acc[r][6], acc[r][7]); *(u32x4*)o = w; }
        }
          }
    }
}
    SEAM(1);

    if (IN(2) && !(FASTMASK & 1)) {
        PHASE_IDS();
        const float* qg = args.in[3]; const float* kg = args.in[4];
        for (int it = gw; it < NTOK * 24; it += NGW) {
            const int tok = it / 24, hh = it % 24; const int isk = hh >= 12; const int pos = tok & (SEQ - 1);
            bf16* p = QKV + (size_t)tok * QKVW + hh * 128 + 2 * PL;
            const unsigned raw = *(const unsigned*)p;
            float a = bf2f((bf16)(raw & 0xffff)), b = bf2f((bf16)(raw >> 16));
            const float ss = wave_sum(a * a + b * b);
            const float rstd = 1.0f / sqrtf(ss * (1.f / 128.f) + EPS);
            const float* gg = (isk ? kg : qg) + 2 * PL;
            a = a * rstd * gg[0]; b = b * rstd * gg[1];
            const float pa = __shfl_xor(a, 8), pb = __shfl_xor(b, 8);
            if (PL < 16) {
                const int d0 = (2 * PL) & 15;
                const float c0 = ROPE[(pos * 16 + d0) * 2], s0 = ROPE[(pos * 16 + d0) * 2 + 1], c1 = ROPE[(pos * 16 + d0 + 1) * 2], s1 = ROPE[(pos * 16 + d0 + 1) * 2 + 1];
                if (PL < 8) { a = a * c0 - pa * s0; b = b * c1 - pb * s1; }
                else { a = a * c0 + pa * s0; b = b * c1 + pb * s1; }
            }
            *(unsigned*)p = pk2(a, b);
        }
    }
    if (!(FASTMASK & 1)) SEAM(2);

    if (IN(3)) {
        PHASE_IDS();
#pragma unroll 1
        for (int rep_ = 0; rep_ <= ((REPMASK >> 3) & 1); ++rep_) {
      if constexpr (FASTMASK & 256) {
        LAS unsigned char* Kim = F.lds; LAS unsigned char* Vim = F.lds + 65536;
        const int fr = PL & 15, fq = PL >> 4;
        constexpr int NITEM = BATCH * NHEAD * 16;
#pragma unroll 1
        for (int it = vcu; it < NITEM; it += F.G) {
            const int b = it / (NHEAD * 16), h = (it >> 4) % NHEAD, sub = it & 15; const int grp = h >> 2;
            const int dsh = 2 * grp, dil = 1 << dsh, L = SEQ >> dsh, nqbs = 4 - dsh;
            const int r = sub >> nqbs, qb = sub & ((1 << nqbs) - 1);
            const int kbase = 128 * qb - 64;
            { const int c = PT & 15, row0 = PT >> 4;
              u32x4 kv[8], vv[8];
#pragma unroll
              for (int i = 0; i < 8; ++i) { const int row = row0 + 32 * i, jk = kbase + row; const bool ok = (jk >= 0) && (jk < L);
                  const bf16* src = QKV + (size_t)((b << 11) + (ok ? jk : 0) * dil + r) * QKVW + AW + h * 128 + 8 * c;
                  kv[i] = ok ? *(const u32x4*)src : (u32x4){0u, 0u, 0u, 0u}; vv[i] = ok ? *(const u32x4*)(src + AW) : (u32x4){0u, 0u, 0u, 0u}; }
#pragma unroll
              for (int i = 0; i < 8; ++i) { const int row = row0 + 32 * i; const int fx = (row & 3) | (((row >> 3) & 3) << 2);
                  *(LAS u32x4*)(Kim + row * 256 + ((c ^ fx) << 4)) = kv[i];
                  *(LAS u32x4*)(Vim + row * 288 + ((16 * c) ^ (((row >> 3) & 1) << 7))) = vv[i]; } }
            const int jq0 = 128 * qb + 16 * PW;
            bf16x8 qf[4];
            { const bf16* qp = QKV + (size_t)((b << 11) + (jq0 + fr) * dil + r) * QKVW + h * 128 + 8 * fq;
#pragma unroll
              for (int k = 0; k < 4; ++k) qf[k] = *(const bf16x8*)(qp + 32 * k); }
            __syncthreads();
            const int a0 = PW >> 1;
            f32x4 sreg[5][2];
#pragma unroll
            for (int st = 0; st < 5; ++st)
#pragma unroll
                for (int t2 = 0; t2 < 2; ++t2) { f32x4 acc = {0.f, 0.f, 0.f, 0.f};
                    const int krow = 32 * (a0 + st) + 8 * (fr >> 2) + 4 * t2 + (fr & 3);
#pragma unroll
                    for (int k = 0; k < 4; ++k) { const bf16x8 kf = *(const LAS bf16x8*)(Kim + krow * 256 + (((4 * k + fq) ^ fr) << 4));
                        acc = __builtin_amdgcn_mfma_f32_16x16x32_bf16(kf, qf[k], acc, 0, 0, 0); }
                    sreg[st][t2] = acc; }
            const int jq = jq0 + fr; float mx = -3.0e38f;
#pragma unroll
            for (int st = 0; st < 5; ++st)
#pragma unroll
                for (int t2 = 0; t2 < 2; ++t2)
#pragma unroll
                    for (int j = 0; j < 4; ++j) { const int jk = kbase + 32 * (a0 + st) + 8 * fq + 4 * t2 + j; const int dlt = jk - jq;
                        const bool ok = (dlt <= 64) && (dlt >= -64) && (jk >= 0) && (jk < L);
                        const float sv = ok ? sreg[st][t2][j] * 0.08838834764831845f : -1.0e30f; sreg[st][t2][j] = sv; mx = fmaxf(mx, sv); }
            mx = fmaxf(mx, xshfl<16>(mx)); mx = half_max(mx);
            float sum = 0.f; bf16x8 pf[5];
#pragma unroll
            for (int st = 0; st < 5; ++st) { float pv[8];
#pragma unroll
                for (int t2 = 0; t2 < 2; ++t2)
#pragma unroll
                    for (int j = 0; j < 4; ++j) { const float sv = sreg[st][t2][j]; const float p = (sv > -1.0e29f) ? __expf(sv - mx) : 0.f; pv[4 * t2 + j] = p; sum += p; }
                u32x4 w; w.x = cvtpk(pv[0], pv[1]); w.y = cvtpk(pv[2], pv[3]); w.z = cvtpk(pv[4], pv[5]); w.w = cvtpk(pv[6], pv[7]); pf[st] = __builtin_bit_cast(bf16x8, w); }
            sum += xshfl<16>(sum); sum = half_sum(sum);
            f32x4 oacc[8];
#pragma unroll
            for (int nt = 0; nt < 8; ++nt) oacc[nt] = (f32x4){0.f, 0.f, 0.f, 0.f};
            { const int g = fq, q = (PL & 15) >> 2, p = PL & 3;
              const int vb0 = (8 * g + q) * 288 + ((8 * p) ^ ((g & 1) << 7)), vb1 = (8 * g + q) * 288 + ((128 + 8 * p) ^ ((g & 1) << 7));
#pragma unroll
              for (int st = 0; st < 5; ++st)
#pragma unroll
                  for (int nt = 0; nt < 8; ++nt) { s16x4 hh[2];
#pragma unroll
                      for (int tt = 0; tt < 2; ++tt) hh[tt] = __builtin_amdgcn_ds_read_tr16_b64_v4i16((LAS s16x4*)(Vim + ((nt & 4) ? vb1 : vb0) + (32 * (a0 + st) + 4 * tt) * 288 + 32 * (nt & 3)));
                      const bf16x8 vf = __builtin_shufflevector(hh[0], hh[1], 0, 1, 2, 3, 4, 5, 6, 7);
                      oacc[nt] = __builtin_amdgcn_mfma_f32_16x16x32_bf16(vf, pf[st], oacc[nt], 0, 0, 0); } }
            const float inv = 1.0f / sum; const int tokq = (b << 11) + jq * dil + r;
            bf16* op = Ob + (size_t)tokq * AW + h * 128 + 4 * fq;
#pragma unroll
            for (int nt = 0; nt < 8; ++nt) { u32x2 w; w.x = cvtpk(oacc[nt][0] * inv, oacc[nt][1] * inv); w.y = cvtpk(oacc[nt][2] * inv, oacc[nt][3] * inv); *(u32x2*)(op + 16 * nt) = w; }
            if (fq == 0) LSE[tokq * NHEAD + h] = mx + __logf(sum);
            __syncthreads();
        }
      } else {
        LAS float* qs = (LAS float*)(F.lds + PW * 2048);
        LAS float* ps = qs + 128;
        for (int it = gw; it < NTOK * NHEAD; it += NGW) {
            const int tok = it / NHEAD, h = it % NHEAD; const int b = tok >> 11, s = tok & 2047;
            const int grp = h >> 2; const int dil = grp == 0 ? 1 : (grp == 1 ? 4 : 16); const int L = SEQ / dil;
            const int j = s / dil, r = s % dil;
            const int jlo = max(0, j - 64), jhi = min(L - 1, j + 64); const int nk = jhi - jlo + 1;
            { const unsigned raw = *(const unsigned*)(QKV + (size_t)tok * QKVW + h * 128 + 2 * PL); qs[2 * PL] = bf2f((bf16)(raw & 0xffff)); qs[2 * PL + 1] = bf2f((bf16)(raw >> 16)); }
            asm volatile("s_waitcnt lgkmcnt(0)" ::: "memory");
            float sc[3]; float mx = -3.0e38f;
#pragma unroll
            for (int q = 0; q < 3; ++q) { const int ki = PL + 64 * q; sc[q] = -3.0e38f;
                if (ki < nk) { const int tk = (b << 11) + (jlo + ki) * dil + r; const bf16* kp = QKV + (size_t)tk * QKVW + AW + h * 128; float d = 0.f;
                    for (int c = 0; c < 16; ++c) { const u32x4 kv = *(const u32x4*)(kp + 8 * c); const unsigned w[4] = {kv.x, kv.y, kv.z, kv.w};
#pragma unroll
                        for (int e = 0; e < 4; ++e) { d += qs[8 * c + 2 * e] * bf2f((bf16)(w[e] & 0xffff)) + qs[8 * c + 2 * e + 1] * bf2f((bf16)(w[e] >> 16)); } }
                    sc[q] = d * 0.08838834764831845f; mx = fmaxf(mx, sc[q]); } }
            mx = wave_max(mx);
            float sum = 0.f;
#pragma unroll
            for (int q = 0; q < 3; ++q) { const int ki = PL + 64 * q; const float p = (ki < nk) ? __expf(sc[q] - mx) : 0.f; sum += p; ps[ki] = p; }
            sum = wave_sum(sum);
            asm volatile("s_waitcnt lgkmcnt(0)" ::: "memory");
            float o0 = 0.f, o1 = 0.f;
            for (int ki = 0; ki < nk; ++ki) { const int tk = (b << 11) + (jlo + ki) * dil + r; const unsigned raw = *(const unsigned*)(QKV + (size_t)tk * QKVW + 2 * AW + h * 128 + 2 * PL);
                const float p = ps[ki]; o0 += p * bf2f((bf16)(raw & 0xffff)); o1 += p * bf2f((bf16)(raw >> 16)); }
            const float inv = 1.0f / sum;
            *(unsigned*)(Ob + (size_t)tok * AW + h * 128 + 2 * PL) = pk2(o0 * inv, o1 * inv);
            if (PL == 0) LSE[tok * NHEAD + h] = mx + __logf(sum);
            asm volatile("s_waitcnt lgkmcnt(0)" ::: "memory");
        }
          }
    }
}
    SEAM(3);

    if (IN(4) && !(FASTMASK & 2)) {
        PHASE_IDS();
#pragma unroll 1
        for (int rep_ = 0; rep_ <= ((REPMASK >> 4) & 1); ++rep_) {
        for (int i0 = gt; i0 < NTOK * (AW / 8); i0 += 4 * NGT) {
            u32x4 vv[4]; float al[4];
#pragma unroll
            for (int q = 0; q < 4; ++q) { const int i = i0 + q * NGT; const int tok = i / (AW / 8), c = i % (AW / 8); const int h = c >> 4, hg = h & 3;
                const float l0 = LSE[tok * NHEAD + hg], l1 = LSE[tok * NHEAD + 4 + hg], l2 = LSE[tok * NHEAD + 8 + hg];
                vv[q] = *(const u32x4*)(Ob + (size_t)tok * AW + c * 8);
                const float m = fmaxf(l0, fmaxf(l1, l2)); const float e0 = __expf(l0 - m), e1 = __expf(l1 - m), e2 = __expf(l2 - m);
                const float mine = (h >> 2) == 0 ? e0 : ((h >> 2) == 1 ? e1 : e2); al[q] = mine / (e0 + e1 + e2); }
#pragma unroll
            for (int q = 0; q < 4; ++q) { const int i = i0 + q * NGT; const int tok = i / (AW / 8), c = i % (AW / 8); const u32x4 v = vv[q]; const float a = al[q]; u32x4 o;
                o.x = cvtpk(bf2f((bf16)(v.x & 0xffff)) * a, bf2f((bf16)(v.x >> 16)) * a); o.y = cvtpk(bf2f((bf16)(v.y & 0xffff)) * a, bf2f((bf16)(v.y >> 16)) * a);
                o.z = cvtpk(bf2f((bf16)(v.z & 0xffff)) * a, bf2f((bf16)(v.z >> 16)) * a); o.w = cvtpk(bf2f((bf16)(v.w & 0xffff)) * a, bf2f((bf16)(v.w >> 16)) * a);
                *(u32x4*)(MIXb + (size_t)tok * AW + c * 8) = o; }
        }
    }
}
    if (!(FASTMASK & 2)) SEAM(4);

    if (IN(5)) {
        PHASE_IDS();
#pragma unroll 1
        for (int rep_ = 0; rep_ <= ((REPMASK >> 5) & 1); ++rep_) {
      if constexpr (FASTMASK & 2) {
        const int wid = PW, lane = PL;
        constexpr int NCT = DM / 256, NU = (NTOK / 256) * NCT;
        for (int u = vcu; u < NU; u += F.G) {
            const int pm = u / NCT, pn = u % NCT;
            MixA al; GldsKc bl;
            al.init(Ob, LSE, pm * 256, PT);
            bl.init(WoT, [&](int R) { return (pn * 256 + R) * AW; }, PT);
            f32x4 acc[8][4];
            fgemm2<0, 0>(F.lds, al, bl, AW / 64, acc, PT);
                    EPI_IDS();
#pragma unroll
            for (int mh = 0; mh < 2; ++mh) {
                u32x2 xr[4][4];
#pragma unroll
                for (int m = 0; m < 4; ++m) { const size_t off = (size_t)(pm * 256 + wr * 128 + (mh * 4 + m) * 16 + fr) * DM + pn * 256 + wc * 64 + 4 * fq;
#pragma unroll
                    for (int n = 0; n < 4; ++n) xr[m][n] = *(const u32x2*)(Hb + off + n * 16); }
#pragma unroll
                for (int m = 0; m < 4; ++m) { const int row = pm * 256 + wr * 128 + (mh * 4 + m) * 16 + fr; const size_t off = (size_t)row * DM + pn * 256 + wc * 64 + 4 * fq; float ss = 0.f;
#pragma unroll
                    for (int n = 0; n < 4; ++n) { const f32x4 v = unpk4(xr[m][n]) + acc[mh * 4 + m][n]; u32x2 w; w.x = cvtpk(v.x, v.y); w.y = cvtpk(v.z, v.w); *(u32x2*)(XAh + off + n * 16) = w; ss += (v.x * v.x + v.y * v.y) + (v.z * v.z + v.w * v.w); }
                    ss += xshfl<16>(ss); ss = half_sum(ss); if (fq == 0) SSQ[row * 32 + pn * 4 + wc] = ss; } }
        }
      } else {
        LAS float* sm = (LAS float*)F.lds; const int ty = PT >> 4, tx = PT & 15;
        const int NU = (NTOK / 128) * (DM / 128);
        for (int u = F.bid; u < NU; u += F.G) {
            const int pm = u / (DM / 128), pn = u % (DM / 128);
            float acc[4][8];
            const bf16* Ap = MIXb + (size_t)pm * 128 * AW; const bf16* Bp = WoT + (size_t)pn * 128 * AW;
            ngemm_tile<true, true>(sm, AW, [&](int i, int k) { return bf2f(Ap[(size_t)i * AW + k]); }, [&](int k, int j) { return bf2f(Bp[(size_t)j * AW + k]); }, acc);
#pragma unroll
            for (int r = 0; r < 4; ++r) { const size_t off = (size_t)(pm * 128 + ty * 4 + r) * DM + pn * 128 + tx * 8;
                const f32x4 x0 = *(const f32x4*)(args.in[0] + off), x1 = *(const f32x4*)(args.in[0] + off + 4);
                *(f32x4*)(XA + off) = (f32x4){x0.x + acc[r][0], x0.y + acc[r][1], x0.z + acc[r][2], x0.w + acc[r][3]};
                *(f32x4*)(XA + off + 4) = (f32x4){x1.x + acc[r][4], x1.y + acc[r][5], x1.z + acc[r][6], x1.w + acc[r][7]}; }
        }
          }
    }
}
    SEAM(5);

#pragma unroll 1
    for (int layer = 0; layer < 2; ++layer) {
        const int PB = layer == 0 ? 6 : 13;
        const float* xin = XA;
        const float* mg = args.in[9] + layer * DM;
        const float* wrg = args.in[10] + (size_t)layer * DM * 8; const float* brg = args.in[11] + layer * 8;
        const float* wre = args.in[12] + (size_t)layer * DM * 64; const float* bre = args.in[13] + layer * 64;
        const float* wgate = args.in[14] + (size_t)layer * NE * DM * DE; const float* wup = args.in[15] + (size_t)layer * NE * DM * DE; const float* wdown = args.in[16] + (size_t)layer * NE * DE * DM;
        unsigned* cnt = CNT + layer * 64; unsigned* done = ctl + CW_DONE + layer * 4096; unsigned* qhead = ctl + CW_Q + layer * 64;

        if (IN(PB)) {
            PHASE_IDS();
          if constexpr (FASTMASK & 128) {
            const bf16* RThi = (const bf16*)(ws + WS_RTAB) + (size_t)(layer * 2) * 80 * DM; const bf16* RTlo = RThi + (size_t)80 * DM;
            const int th = PW >> 2, kq = PW & 3;
            LAS float* Ls = (LAS float*)(F.lds + (th * 4 + kq) * 10240);
            const int fr = PL & 15, fq = PL >> 4;
            const int NTASK = NTOK / 64;
#pragma unroll 1
            for (int rep_ = 0; rep_ <= ((REPMASK >> 6) & 1); ++rep_)
#pragma unroll 1
            for (int tb = F.bid; tb < NTASK; tb += F.G) {
                const int tok0 = tb * 64 + th * 32;
                float myr[2];
#pragma unroll
                for (int rg = 0; rg < 2; ++rg) { const f32x4* sp = (const f32x4*)(SSQ + (size_t)(tok0 + 16 * rg + fr) * 32); float sq = 0.f;
#pragma unroll
                  for (int j = 0; j < 8; ++j) { const f32x4 v = sp[j]; sq += (v.x + v.y) + (v.z + v.w); }
                  myr[rg] = 1.0f / sqrtf(sq * (1.f / DM) + EPS); }
                f32x4 acc[2][5];
#pragma unroll
                for (int rg = 0; rg < 2; ++rg)
#pragma unroll
                    for (int n = 0; n < 5; ++n) acc[rg][n] = (f32x4){0.f, 0.f, 0.f, 0.f};
                const bf16* xrow = XAh + (size_t)(tok0 + fr) * DM + 8 * fq + kq * (DM / 4); const float* grow = mg + 8 * fq + kq * (DM / 4); bf16* hrow = Hb + (size_t)(tok0 + fr) * DM + 8 * fq + kq * (DM / 4);
                const bf16* bh = RThi + ((size_t)(kq * 16) * 5 * 64 + PL) * 8; const bf16* bl = RTlo + ((size_t)(kq * 16) * 5 * 64 + PL) * 8;
                u32x4 cx[2], nx[2]; f32x4 cg[2], ng[2]; bf16x8 cwh[5], cwl[5], nwh[5], nwl[5];
#define RT_LOAD(ks, x_, g_, wh_, wl_) do { x_[0] = *(const u32x4*)(xrow + 32 * (ks)); x_[1] = *(const u32x4*)(xrow + 16 * DM + 32 * (ks)); \
                        g_[0] = *(const f32x4*)(grow + 32 * (ks)); g_[1] = *(const f32x4*)(grow + 32 * (ks) + 4); \
                        _Pragma("unroll") for (int n = 0; n < 5; ++n) { wh_[n] = *(const bf16x8*)(bh + (size_t)((ks) * 5 + n) * 512); wl_[n] = *(const bf16x8*)(bl + (size_t)((ks) * 5 + n) * 512); } } while (0)
#define RT_STEP(ks, x_, g_, wh_, wl_) do { _Pragma("unroll") for (int rg = 0; rg < 2; ++rg) { const u32x4 xw_ = x_[rg]; const f32x4 xa = unpk4((u32x2){xw_.x, xw_.y}), xb = unpk4((u32x2){xw_.z, xw_.w}); const float mr = myr[rg]; \
                        float hv[8] = {xa.x * mr * g_[0].x, xa.y * mr * g_[0].y, xa.z * mr * g_[0].z, xa.w * mr * g_[0].w, xb.x * mr * g_[1].x, xb.y * mr * g_[1].y, xb.z * mr * g_[1].z, xb.w * mr * g_[1].w}; \
                        u32x4 hi, lo; unsigned* hp = (unsigned*)&hi; unsigned* lp = (unsigned*)&lo; \
                        _Pragma("unroll") for (int j = 0; j < 4; ++j) { const unsigned h2 = cvtpk(hv[2 * j], hv[2 * j + 1]); hp[j] = h2; \
                            lp[j] = cvtpk(hv[2 * j] - __uint_as_float(h2 << 16), hv[2 * j + 1] - __uint_as_float(h2 & 0xffff0000u)); } \
                        *(u32x4*)(hrow + (size_t)rg * 16 * DM + 32 * (ks)) = hi; \
                        const bf16x8 ah = __builtin_bit_cast(bf16x8, hi), al_ = __builtin_bit_cast(bf16x8, lo); \
                        _Pragma("unroll") for (int n = 0; n < 5; ++n) { \
                            acc[rg][n] = __builtin_amdgcn_mfma_f32_16x16x32_bf16(ah, wh_[n], acc[rg][n], 0, 0, 0); \
                            acc[rg][n] = __builtin_amdgcn_mfma_f32_16x16x32_bf16(ah, wl_[n], acc[rg][n], 0, 0, 0); \
                            acc[rg][n] = __builtin_amdgcn_mfma_f32_16x16x32_bf16(al_, wh_[n], acc[rg][n], 0, 0, 0); } } } while (0)
                RT_LOAD(0, cx, cg, cwh, cwl);
#pragma unroll 1
                for (int ks = 0; ks < 16; ks += 2) {
                    RT_LOAD(ks + 1, nx, ng, nwh, nwl);
                    __builtin_amdgcn_sched_barrier(0);
                    RT_STEP(ks, cx, cg, cwh, cwl);
                    __builtin_amdgcn_sched_barrier(0);
                    { const int k2 = (ks + 2 < 16) ? ks + 2 : ks; RT_LOAD(k2, cx, cg, cwh, cwl); }
                    __builtin_amdgcn_sched_barrier(0);
                    RT_STEP(ks + 1, nx, ng, nwh, nwl);
                    __builtin_amdgcn_sched_barrier(0);
                }
#undef RT_STEP
#undef RT_LOAD
#pragma unroll
                for (int rg = 0; rg < 2; ++rg)
#pragma unroll
                    for (int n = 0; n < 5; ++n)
#pragma unroll
                        for (int j = 0; j < 4; ++j) Ls[(16 * rg + 4 * fq + j) * 80 + n * 16 + fr] = acc[rg][n][j];
                __syncthreads();
                if (kq == 0 && PL < 32 && rep_ == ((REPMASK >> 6) & 1)) {
                    const int tok = tok0 + PL; const LAS float* L = Ls + PL * 80;
#define LG(i_) (L[i_] + L[2560 + (i_)] + L[5120 + (i_)] + L[7680 + (i_)])
                    float cm = LG(0) + brg[0]; int gsel = 0; float cv[8]; cv[0] = cm;
#pragma unroll
                    for (int j = 1; j < 8; ++j) { cv[j] = LG(j) + brg[j]; if (cv[j] > cm) { cm = cv[j]; gsel = j; } }
                    float cs = 0.f;
#pragma unroll
                    for (int j = 0; j < 8; ++j) cs += __expf(cv[j] - cm);
                    const float ggate = 1.0f / cs;
                    float f1 = -3.0e38f, f2 = -3.0e38f; int i1 = 0, i2 = 0;
                    const f32x4 be0 = *(const f32x4*)(bre + gsel * 8), be1 = *(const f32x4*)(bre + gsel * 8 + 4);
                    const float bb[8] = {be0.x, be0.y, be0.z, be0.w, be1.x, be1.y, be1.z, be1.w};
#pragma unroll
                    for (int j = 0; j < 8; ++j) { const float fv = LG(8 + gsel * 8 + j) + bb[j];
                        const bool g1 = fv > f1, g2 = fv > f2;
                        f2 = g1 ? f1 : (g2 ? fv : f2); i2 = g1 ? i1 : (g2 ? j : i2); f1 = g1 ? fv : f1; i1 = g1 ? j : i1; }
#undef LG
                    const float e2 = __expf(f2 - f1); const float w1 = ggate / (1.0f + e2), w2 = ggate * e2 / (1.0f + e2);
                    const int ex1 = gsel * 8 + i1, ex2 = gsel * 8 + i2;
                    const int p1 = (int)atomicAdd(cnt + ex1, 1u), p2 = (int)atomicAdd(cnt + ex2, 1u);
                    TOKL[ex1 * NTOK + p1] = tok; TOKL[ex2 * NTOK + p2] = tok;
                    SLOT[tok * 4 + 0] = ex1; SLOT[tok * 4 + 1] = p1; SLOT[tok * 4 + 2] = ex2; SLOT[tok * 4 + 3] = p2;
                    SLOTW[tok * 2] = w1; SLOTW[tok * 2 + 1] = w2;
                }
                __syncthreads();
            }
          } else {
            LAS float* hs = (LAS float*)(F.lds + PW * 8192);
            for (int tok = gw; tok < NTOK; tok += NGW) {
                const f32x4* xr = (const f32x4*)(xin + (size_t)tok * DM) + PL; const f32x4* gr = (const f32x4*)mg + PL;
                f32x4 v[8]; float s = 0.f;
#pragma unroll
                for (int j = 0; j < 8; ++j) { v[j] = xr[64 * j]; s += (v[j].x * v[j].x + v[j].y * v[j].y) + (v[j].z * v[j].z + v[j].w * v[j].w); }
                const float rstd = 1.0f / sqrtf(wave_sum(s) * (1.f / DM) + EPS);
                u32x2* o8 = (u32x2*)(Hb + (size_t)tok * DM) + PL;
#pragma unroll
                for (int j = 0; j < 8; ++j) { const f32x4 gg = gr[64 * j]; f32x4 hv = {v[j].x * rstd * gg.x, v[j].y * rstd * gg.y, v[j].z * rstd * gg.z, v[j].w * rstd * gg.w};
                    u32x2 w; w.x = pk2(hv.x, hv.y); w.y = pk2(hv.z, hv.w); o8[64 * j] = w; ((LAS f32x4*)hs)[PL + 64 * j] = hv; }
                asm volatile("s_waitcnt lgkmcnt(0)" ::: "memory");
                float fine = 0.f, coarse = 0.f;
                for (int d = 0; d < DM; ++d) { const float hv = hs[d]; fine += hv * wre[d * 64 + PL]; coarse += hv * wrg[d * 8 + (PL & 7)]; }
                fine += bre[PL]; coarse += brg[PL & 7];
                float cm = coarse; int ci = PL & 7;
#pragma unroll
                for (int o = 1; o < 8; o <<= 1) { const float om = __shfl_xor(cm, o); const int oi = __shfl_xor(ci, o); if (om > cm || (om == cm && oi < ci)) { cm = om; ci = oi; } }
                float ce = __expf(coarse - cm); float cs = ce;
#pragma unroll
                for (int o = 1; o < 8; o <<= 1) cs += __shfl_xor(cs, o);
                const float ggate = 1.0f / cs;
                const int gsel = __shfl(ci, 0); const float gg0 = __shfl(ggate, 0);
                float f1 = __shfl(fine, gsel * 8 + (PL & 7)); int i1 = PL & 7; const float fmine = f1;
#pragma unroll
                for (int o = 1; o < 8; o <<= 1) { const float om = __shfl_xor(f1, o); const int oi = __shfl_xor(i1, o); if (om > f1 || (om == f1 && oi < i1)) { f1 = om; i1 = oi; } }
                float f2 = ((PL & 7) == i1) ? -3.0e38f : fmine; int i2 = PL & 7;
#pragma unroll
                for (int o = 1; o < 8; o <<= 1) { const float om = __shfl_xor(f2, o); const int oi = __shfl_xor(i2, o); if (om > f2 || (om == f2 && oi < i2)) { f2 = om; i2 = oi; } }
                if (PL == 0) {
                    const float e2 = __expf(f2 - f1); const float w1 = gg0 / (1.0f + e2), w2 = gg0 * e2 / (1.0f + e2);
                    const int ex1 = gsel * 8 + i1, ex2 = gsel * 8 + i2;
                    const int p1 = (int)atomicAdd(cnt + ex1, 1u), p2 = (int)atomicAdd(cnt + ex2, 1u);
                    TOKL[ex1 * NTOK + p1] = tok; TOKL[ex2 * NTOK + p2] = tok;
                    SLOT[tok * 4 + 0] = ex1; SLOT[tok * 4 + 1] = p1; SLOT[tok * 4 + 2] = ex2; SLOT[tok * 4 + 3] = p2;
                    SLOTW[tok * 2] = w1; SLOTW[tok * 2 + 1] = w2;
                }
                asm volatile("s_waitcnt lgkmcnt(0)" ::: "memory");
            }
                  }
        }
        SEAM(PB);

        if (IN(PB + 1)) {
            PHASE_IDS();
#pragma unroll 1
        for (int rep_ = 0; rep_ <= ((REPMASK >> 7) & 1); ++rep_) {
            LAS int* tab = (LAS int*)(F.lds + MISC_OFF + 1024); moe_load_tab(tab, cnt, PT);
          if constexpr (FASTMASK & 4) {
            const int wid = PW, lane = PL;
            int u0 = 0;
#pragma unroll 1
            for (int e = 0; e < NE; ++e) {
                const int c = tab[e], nrt = (c + 255) >> 8, nu = nrt * 4, off = tab[NE + e];
#pragma unroll 1
                for (int u = u0 + ((vcu - (u0 % F.G) + F.G) % F.G); u < u0 + nu; u += F.G) {
                    const int ul = u - u0, ct = ul / nrt, rt = ul % nrt;
                    const int* tl = TOKL + e * NTOK + rt * 256; const int nrow = c - rt * 256;
                    const bool dummy_ = (PROBE_SAMEW && rep_ == 0 && ((REPMASK >> 7) & 1)); const int ew = dummy_ ? (PROBE_SAMEW == 4 ? ((e + 17 * rt + 5 * ct) & 63) : 0) : e, ctw = (dummy_ && PROBE_SAMEW >= 2 && PROBE_SAMEW != 4) ? 0 : ct;
                    const float* wg = wgate + (size_t)ew * DM * DE + ctw * 128; const float* wu = wup + (size_t)ew * DM * DE + ctw * 128;
                    GldsKc al; KnF32Loader bl;
                    const int tu_ = MY_TID(); const int lane = tu_ & 63, wid = PW;
                    int tk[4];
#pragma unroll
                    for (int i = 0; i < 4; ++i) tk[i] = tl[min((tu_ >> 3) + 64 * i, nrow - 1)];
                    asm volatile("" : "+v"(tk[0]), "+v"(tk[1]), "+v"(tk[2]), "+v"(tk[3]));
                    al.init_i(Hb, [&](int, int i) { return tk[i] * DM; }, tu_);
                    { const int n0 = 4 * lane, wcc = n0 >> 6, nn = (n0 >> 4) & 3; bl.init((nn < 2 ? wg : wu) + wcc * 32 + (nn & 1) * 16 + (n0 & 15) + (size_t)wid * DE, DE); }
                    if (PROBE_SAMEW == 3 && dummy_) bl.init(wgate + 4 * lane, 0);
                    f32x4 acc[8][4];
                    fgemm2<0, 1>(F.lds, al, bl, DM / 64, acc, PT);
                    EPI_IDS();
#pragma unroll
                    for (int m = 0; m < 8; ++m) { if (wr * 128 + m * 16 + fr >= nrow) continue;
                        bf16* o = Ab + (size_t)(off + rt * 256 + wr * 128 + m * 16 + fr) * DE + ct * 128 + wc * 32 + 4 * fq;
#pragma unroll
                        for (int n = 0; n < 2; ++n) { float a[4];
#pragma unroll
                            for (int j = 0; j < 4; ++j) { const float gv = acc[m][n][j]; a[j] = gv / (1.0f + __expf(-gv)) * acc[m][n + 2][j]; }
                            u32x2 w; w.x = cvtpk(a[0], a[1]); w.y = cvtpk(a[2], a[3]); *(u32x2*)(o + n * 16) = w; } }
                    asm volatile("s_waitcnt vmcnt(0)" ::: "memory"); __syncthreads();
                    if (MY_TID() == 0) { __builtin_amdgcn_fence(__ATOMIC_RELEASE, "agent"); (void)xb_add(done + e * 64 + rt, 1u); }
                }
                u0 += nu;
            }
          } else {
            LAS float* sm = (LAS float*)F.lds; const int ty = PT >> 4, tx = PT & 15;
            int u0 = 0;
            for (int e = 0; e < NE; ++e) {
                const int c = tab[e], nrt = (c + 127) >> 7, nu = nrt * 4, off = tab[NE + e];
                for (int u = u0 + ((F.bid - (u0 % F.G) + F.G) % F.G); u < u0 + nu; u += F.G) {
                    const int ul = u - u0, rt = ul >> 2, ct = ul & 3;
                    const int* tl = TOKL + e * NTOK + rt * 128; const int nrow = min(128, c - rt * 128);
                    const float* wg = wgate + (size_t)e * DM * DE + ct * 128; const float* wu = wup + (size_t)e * DM * DE + ct * 128;
                    float accg[4][8], accu[4][8];
                    auto af = [&](int i, int k) { const int t = (i < nrow) ? tl[i] : 0; return bf2f(Hb[(size_t)t * DM + k]); };
                    ngemm_tile<true, false>(sm, DM, af, [&](int k, int j) { return bf2f((bf16)f2bf(wg[(size_t)k * DE + j])); }, accg);
                    ngemm_tile<true, false>(sm, DM, af, [&](int k, int j) { return bf2f((bf16)f2bf(wu[(size_t)k * DE + j])); }, accu);
#pragma unroll
                    for (int r = 0; r < 4; ++r) { bf16* o = Ab + (size_t)(off + rt * 128 + ty * 4 + r) * DE + ct * 128 + tx * 8; float a[8];
#pragma unroll
                        for (int q = 0; q < 8; ++q) { const float g = accg[r][q]; a[q] = g / (1.0f + __expf(-g)) * accu[r][q]; }
                        u32x4 w; w.x = pk2(a[0], a[1]); w.y = pk2(a[2], a[3]); w.z = pk2(a[4], a[5]); w.w = pk2(a[6], a[7]); *(u32x4*)o = w; }
                }
                u0 += nu;
            }
                  }
        }
}

        if (IN(PB + 2)) {
            PHASE_IDS();
#pragma unroll 1
        for (int rep_ = 0; rep_ <= ((REPMASK >> 8) & 1); ++rep_) {
            LAS int* tab = (LAS int*)(F.lds + MISC_OFF + 1024); moe_load_tab(tab, cnt, PT);
          if constexpr (FASTMASK & 8) {
            { const int t0_ = MY_TID(); if (t0_ < NE) { int lo_ = 0; for (int e2 = (t0_ & 7); e2 < t0_; e2 += 8) lo_ += ((tab[e2] + 255) >> 8) * 8; tab[128 + t0_] = lo_; }
              if (t0_ == 0) MISC[22] = bar.x & 7u; }
            __syncthreads();
#define G2_FETCH() do { unsigned cur_ = MISC[22], res_ = 0xffffffffu; \
                for (int try_ = 0; try_ < 8; ++try_) { const int el_ = 56 + (int)cur_; const unsigned n_ = (unsigned)(tab[128 + el_] + ((tab[el_] + 255) >> 8) * 8); \
                    const unsigned k_ = xb_add(qhead + 8 * cur_, 1u); if (k_ < n_) { res_ = (cur_ << 24) | k_; break; } cur_ = (cur_ + 1u) & 7u; } \
                MISC[22] = cur_; MISC[20] = res_; } while (0)
            { const int t0_ = MY_TID(); if (t0_ == 0) G2_FETCH(); }
#pragma unroll 1
            for (;;) {
                __syncthreads();
                const unsigned qw = (unsigned)__builtin_amdgcn_readfirstlane((int)MISC[20]);
                if (qw == 0xffffffffu) break;
                const int qx = (int)(qw >> 24), q = (int)(qw & 0xffffffu);
                { const int t0_ = MY_TID(); if (t0_ < NE && (t0_ & 7) == qx) { const int lo_ = tab[128 + t0_], hi_ = lo_ + ((tab[t0_] + 255) >> 8) * 8; if (q >= lo_ && q < hi_) MISC[21] = (unsigned)t0_; } }
                __syncthreads();
                const int e = __builtin_amdgcn_readfirstlane((int)MISC[21]);
                const int c = tab[e], nrt = (c + 255) >> 8, off = tab[NE + e];
                const int ul = q - tab[128 + e], ct = ul / nrt, rt = ul % nrt;
                { const int t0_ = MY_TID();
                  if (t0_ == 0) { XB_SPIN(xb_ld(done + e * 64 + rt) < 4u, ctl + CW_BAR); __builtin_amdgcn_fence(__ATOMIC_ACQUIRE, "agent"); } }
                __syncthreads();
                { const int t0_ = MY_TID(); if (t0_ == 0) G2_FETCH(); }
                {
                    const bf16* Ap = Ab + (size_t)(off + rt * 256) * DE; const float* wd = wdown + (size_t)e * DE * DM + ct * 256;
                    GldsKc al; KnF32Loader bl;
                    const int tu_ = MY_TID(); const int lane = tu_ & 63, wid = PW;
                    al.init(Ap, [&](int R) { return R * DE; }, tu_);
                    bl.init(wd + 4 * lane + (size_t)wid * DM, DM);
                    f32x4 acc[8][4];
                    fgemm2<0, 1>(F.lds, al, bl, DE / 64, acc, PT);
                    EPI_IDS();
#pragma unroll
                    for (int m = 0; m < 8; ++m) { if (rt * 256 + wr * 128 + m * 16 + fr >= c) continue;
                        bf16* o = Yb + (size_t)(off + rt * 256 + wr * 128 + m * 16 + fr) * DM + ct * 256 + wc * 64 + 4 * fq;
#pragma unroll
                        for (int n = 0; n < 4; ++n) { u32x2 w; w.x = cvtpk(acc[m][n][0], acc[m][n][1]); w.y = cvtpk(acc[m][n][2], acc[m][n][3]); *(u32x2*)(o + n * 16) = w; } }
                }
            }
#undef G2_FETCH
          } else {
            LAS float* sm = (LAS float*)F.lds; const int ty = PT >> 4, tx = PT & 15;
            int u0 = 0;
            for (int e = 0; e < NE; ++e) {
                const int c = tab[e], nrt = (c + 127) >> 7, nu = nrt * 16, off = tab[NE + e];
                for (int u = u0 + ((F.bid - (u0 % F.G) + F.G) % F.G); u < u0 + nu; u += F.G) {
                    const int ul = u - u0, rt = ul >> 4, ct = ul & 15;
                    const bf16* Ap = Ab + (size_t)(off + rt * 128) * DE; const float* wd = wdown + (size_t)e * DE * DM + ct * 128;
                    float acc[4][8];
                    ngemm_tile<true, false>(sm, DE, [&](int i, int k) { return bf2f(Ap[(size_t)i * DE + k]); }, [&](int k, int j) { return bf2f((bf16)f2bf(wd[(size_t)k * DM + j])); }, acc);
#pragma unroll
                    for (int r = 0; r < 4; ++r) { bf16* o = Yb + (size_t)(off + rt * 128 + ty * 4 + r) * DM + ct * 128 + tx * 8;
                        u32x4 w; w.x = pk2(acc[r][0], acc[r][1]); w.y = pk2(acc[r][2], acc[r][3]); w.z = pk2(acc[r][4], acc[r][5]); w.w = pk2(acc[r][6], acc[r][7]); *(u32x4*)o = w; }
                }
                u0 += nu;
            }
                  }
        }
}
        SEAM(PB + 2);

        if (IN(PB + 3)) {
            PHASE_IDS();
#pragma unroll 1
        for (int rep_ = 0; rep_ <= ((REPMASK >> 9) & 1); ++rep_) {
            LAS int* tab = (LAS int*)(F.lds + MISC_OFF + 1024); moe_load_tab(tab, cnt, PT);
            float* xo = layer == 0 ? XB : F.out; const float* fg = args.in[6];
            const f32x4* grn = (const f32x4*)fg + PL;
            f32x4 gg8[8];
#pragma unroll
            for (int j = 0; j < 8; ++j) gg8[j] = grn[64 * j];
            for (int tok0 = gw * 2; tok0 < NTOK; tok0 += NGW * 2) {
                f32x4 xv[2][8]; u32x2 xh[2][8], ya[2][8], yb[2][8]; float w1[2], w2[2];
#pragma unroll
                for (int r = 0; r < 2; ++r) { const int tok = tok0 + r;
                    const int e1 = SLOT[tok * 4], p1 = SLOT[tok * 4 + 1], e2 = SLOT[tok * 4 + 2], p2 = SLOT[tok * 4 + 3]; w1[r] = SLOTW[tok * 2]; w2[r] = SLOTW[tok * 2 + 1];
                    const u32x2* y1 = (const u32x2*)(Yb + (size_t)(tab[NE + e1] + p1) * DM) + PL; const u32x2* y2 = (const u32x2*)(Yb + (size_t)(tab[NE + e2] + p2) * DM) + PL;
                    const u32x2* xr = (const u32x2*)(XAh + (size_t)tok * DM) + PL;
#pragma unroll
                    for (int j = 0; j < 8; ++j) { xh[r][j] = xr[64 * j]; ya[r][j] = y1[64 * j]; yb[r][j] = y2[64 * j]; } }
#pragma unroll
                for (int r = 0; r < 2; ++r) { const int tok = tok0 + r; float sq = 0.f;
#pragma unroll
                    for (int j = 0; j < 8; ++j) { const u32x2 a = ya[r][j], b = yb[r][j]; f32x4 x = unpk4(xh[r][j]);
                        x.x += w1[r] * bf2f((bf16)(a.x & 0xffff)) + w2[r] * bf2f((bf16)(b.x & 0xffff)); x.y += w1[r] * bf2f((bf16)(a.x >> 16)) + w2[r] * bf2f((bf16)(b.x >> 16));
                        x.z += w1[r] * bf2f((bf16)(a.y & 0xffff)) + w2[r] * bf2f((bf16)(b.y & 0xffff)); x.w += w1[r] * bf2f((bf16)(a.y >> 16)) + w2[r] * bf2f((bf16)(b.y >> 16));
                        xv[r][j] = x; sq += (x.x * x.x + x.y * x.y) + (x.z * x.z + x.w * x.w);
                        if (layer == 0) { u32x2 w; w.x = cvtpk(x.x, x.y); w.y = cvtpk(x.z, x.w); ((u32x2*)(XBh + (size_t)tok * DM))[PL + 64 * j] = w; } else ((f32x4*)(F.out + (size_t)tok * DM))[PL + 64 * j] = x; }
                    if (layer == 0) { const float rstd = 1.0f / sqrtf(wave_sum(sq) * (1.f / DM) + EPS); if (PL == 0) RS2[tok] = rstd; } }
            }
        }
}
        if (layer == 0) {
            SEAM(9);
            if (IN(10)) {
                PHASE_IDS();
#pragma unroll 1
        for (int rep_ = 0; rep_ <= ((REPMASK >> 10) & 1); ++rep_) {
              if constexpr (FASTMASK & 16) {
                const int wid = PW, lane = PL;
                constexpr int NU = 8 * 8 * 8;
                for (int u = vcu; u < NU; u += F.G) {
                    const int pn = u & 7, ip = (u >> 3) & 7, b = u >> 6;
                    GldsKc al, bl;
                    al.init(XBh, [&](int R) { int sq = 128 * ip + (R & 127); if (R >= 128) sq = (sq == 0) ? 1024 : (SEQ - sq); return ((b << 11) + sq) * DM; }, PT);
                    bl.init(WpT, [&](int R) { return (pn * 256 + R) * DM; }, PT);
                    f32x4 acc[8][4];
                    fgemm2<1, 0>(F.lds, al, bl, DM / 64, acc, PT);
                    EPI_IDS();
#pragma unroll
                    for (int m = 0; m < 4; ++m) { const int sq = 128 * ip + wr * 64 + m * 16 + fr; const int sm_ = (sq == 0) ? 1024 : (SEQ - sq);
                        const float rs1 = RS2[(b << 11) + sq], rs2 = RS2[(b << 11) + sm_];
                        bf16* o1 = VSYM + (size_t)((b << 11) + sq) * DM + pn * 256 + wc * 64 + 4 * fq; bf16* o2 = VSYM + (size_t)((b << 11) + sm_) * DM + pn * 256 + wc * 64 + 4 * fq;
#pragma unroll
                        for (int n = 0; n < 4; ++n) { float v1[4], v2[4];
#pragma unroll
                            for (int j = 0; j < 4; ++j) { const int jj = wc * 64 + n * 16 + 4 * fq + j; const float sg = (jj > 128) ? -1.f : 1.f; const float a1 = acc[m][n][j] * rs1, a2 = acc[m + 4][n][j] * rs2;
                                if (sq == 0) { v1[j] = (jj > 128) ? 0.f : 2.f * a1; v2[j] = (jj > 128) ? 0.f : 2.f * a2; } else { v1[j] = a1 + sg * a2; v2[j] = sg * v1[j]; } }
                            u32x2 w1, w2; w1.x = cvtpk(v1[0], v1[1]); w1.y = cvtpk(v1[2], v1[3]); w2.x = cvtpk(v2[0], v2[1]); w2.y = cvtpk(v2[2], v2[3]);
                            *(u32x2*)(o1 + n * 16) = w1; *(u32x2*)(o2 + n * 16) = w2; } }
                }
              } else {
                LAS float* sm = (LAS float*)F.lds; const int ty = PT >> 4, tx = PT & 15;
                const int NU = (NTOK / 128) * (DM / 128);
                for (int u = F.bid; u < NU; u += F.G) {
                    const int pm = u / (DM / 128), pn = u % (DM / 128); const int b = pm >> 4, s0 = (pm & 15) * 128;
                    float acc1[4][8], acc2[4][8];
                    const bf16* Bp = WpT + (size_t)pn * 128 * DM;
                    ngemm_tile<true, true>(sm, DM, [&](int i, int k) { return bf2f(Hb[(size_t)((b << 11) + s0 + i) * DM + k]); }, [&](int k, int j) { return bf2f(Bp[(size_t)j * DM + k]); }, acc1);
                    ngemm_tile<true, true>(sm, DM, [&](int i, int k) { return bf2f(Hb[(size_t)((b << 11) + ((SEQ - (s0 + i)) & 2047)) * DM + k]); }, [&](int k, int j) { return bf2f(Bp[(size_t)j * DM + k]); }, acc2);
#pragma unroll
                    for (int r = 0; r < 4; ++r) { bf16* o = VSYM + (size_t)((b << 11) + s0 + ty * 4 + r) * DM + pn * 128 + tx * 8; float a[8];
#pragma unroll
                        for (int q = 0; q < 8; ++q) { const int col = pn * 128 + tx * 8 + q; const float sg = ((col & 255) > 128) ? -1.f : 1.f; a[q] = acc1[r][q] + sg * acc2[r][q]; }
                        u32x4 w; w.x = pk2(a[0], a[1]); w.y = pk2(a[2], a[3]); w.z = pk2(a[4], a[5]); w.w = pk2(a[6], a[7]); *(u32x4*)o = w; }
                }
                          }
            }
}
            SEAM(10);
            if (IN(11)) {
                PHASE_IDS();
#pragma unroll 1
        for (int rep_ = 0; rep_ <= ((REPMASK >> 11) & 1); ++rep_) {
              if constexpr (FASTMASK & 32) {
                const int wid = PW, lane = PL;
                constexpr int NU = 8 * 8 * 8;
                for (int u = vcu; u < NU; u += F.G) {
                    const int pn = u & 7, kt1 = (u >> 3) & 7, b = u >> 6;
                    GldsKc al; KnBf16Loader bl;
                    al.init(HART, [&](int R) { return (kt1 * 256 + R) * SEQ; }, PT);
                    bl.init(VSYM, (unsigned)(((b << 11) + wid * 2 + (lane >> 5)) * DM + pn * 256 + 8 * (lane & 31)), DM);
                    f32x4 acc[8][4];
                    fgemm2<0, 2>(F.lds, al, bl, SEQ / 64, acc, PT);
                    EPI_IDS();
#pragma unroll
                    for (int m = 0; m < 8; ++m) { bf16* o = Zb + (size_t)((b << 11) + kt1 * 256 + wr * 128 + m * 16 + fr) * DM + pn * 256 + wc * 64 + 4 * fq;
#pragma unroll
                        for (int n = 0; n < 4; ++n) { u32x2 w; w.x = cvtpk(acc[m][n][0], acc[m][n][1]); w.y = cvtpk(acc[m][n][2], acc[m][n][3]); *(u32x2*)(o + n * 16) = w; } }
                }
              } else {
                LAS float* sm = (LAS float*)F.lds; const int ty = PT >> 4, tx = PT & 15;
                const int NU = (NTOK / 128) * (DM / 128);
                for (int u = F.bid; u < NU; u += F.G) {
                    const int pm = u / (DM / 128), pn = u % (DM / 128); const int b = pm >> 4, k10 = (pm & 15) * 128;
                    float acc[4][8];
                    const bf16* Ap = HART + (size_t)k10 * SEQ; const bf16* Bp = VSYM + (size_t)(b << 11) * DM + pn * 128;
                    ngemm_tile<true, false>(sm, SEQ, [&](int i, int k) { return bf2f(Ap[(size_t)i * SEQ + k]); }, [&](int k, int j) { return bf2f(Bp[(size_t)k * DM + j]); }, acc);
#pragma unroll
                    for (int r = 0; r < 4; ++r) { bf16* o = Zb + (size_t)((b << 11) + k10 + ty * 4 + r) * DM + pn * 128 + tx * 8;
                        u32x4 w; w.x = pk2(acc[r][0], acc[r][1]); w.y = pk2(acc[r][2], acc[r][3]); w.z = pk2(acc[r][4], acc[r][5]); w.w = pk2(acc[r][6], acc[r][7]); *(u32x4*)o = w; }
                }
                          }
            }
}
            SEAM(11);
            if (IN(12)) {
                PHASE_IDS();
#pragma unroll 1
        for (int rep_ = 0; rep_ <= ((REPMASK >> 12) & 1); ++rep_) {
              if constexpr (FASTMASK & 64) {
                const int wid = PW, lane = PL;
                constexpr int NCT = DM / 256, NU = (NTOK / 256) * NCT;
                for (int u = vcu; u < NU; u += F.G) {
                    const int pm = u / NCT, pn = u % NCT;
                    GldsKc al, bl;
                    al.init(Zb, [&](int R) { return (pm * 256 + R) * DM; }, PT);
                    bl.init(W2T, [&](int R) { return (pn * 256 + R) * DM; }, PT);
                    f32x4 acc[8][4];
                    fgemm2<0, 0>(F.lds, al, bl, DM / 64, acc, PT);
                    EPI_IDS();
#pragma unroll
                    for (int mh = 0; mh < 2; ++mh) {
                        u32x2 xr[4][4];
#pragma unroll
                        for (int m = 0; m < 4; ++m) { const size_t off = (size_t)(pm * 256 + wr * 128 + (mh * 4 + m) * 16 + fr) * DM + pn * 256 + wc * 64 + 4 * fq;
#pragma unroll
                            for (int n = 0; n < 4; ++n) xr[m][n] = *(const u32x2*)(XBh + off + n * 16); }
#pragma unroll
                        for (int m = 0; m < 4; ++m) { const int row = pm * 256 + wr * 128 + (mh * 4 + m) * 16 + fr; const size_t off = (size_t)row * DM + pn * 256 + wc * 64 + 4 * fq; float ss = 0.f;
#pragma unroll
                            for (int n = 0; n < 4; ++n) { const f32x4 v = unpk4(xr[m][n]) + acc[mh * 4 + m][n]; u32x2 w; w.x = cvtpk(v.x, v.y); w.y = cvtpk(v.z, v.w); *(u32x2*)(XAh + off + n * 16) = w; ss += (v.x * v.x + v.y * v.y) + (v.z * v.z + v.w * v.w); }
                            ss += xshfl<16>(ss); ss = half_sum(ss); if (fq == 0) SSQ[row * 32 + pn * 4 + wc] = ss; } }
                }
              } else {
                LAS float* sm = (LAS float*)F.lds; const int ty = PT >> 4, tx = PT & 15;
                const int NU = (NTOK / 128) * (DM / 128);
                for (int u = F.bid; u < NU; u += F.G) {
                    const int pm = u / (DM / 128), pn = u % (DM / 128);
                    float acc[4][8];
                    const bf16* Ap = Zb + (size_t)pm * 128 * DM; const bf16* Bp = W2T + (size_t)pn * 128 * DM;
                    ngemm_tile<true, true>(sm, DM, [&](int i, int k) { return bf2f(Ap[(size_t)i * DM + k]); }, [&](int k, int j) { return bf2f(Bp[(size_t)j * DM + k]); }, acc);
#pragma unroll
                    for (int r = 0; r < 4; ++r) { const size_t off = (size_t)(pm * 128 + ty * 4 + r) * DM + pn * 128 + tx * 8;
                        const f32x4 x0 = *(const f32x4*)(XB + off), x1 = *(const f32x4*)(XB + off + 4);
                        *(f32x4*)(XA + off) = (f32x4){x0.x + acc[r][0], x0.y + acc[r][1], x0.z + acc[r][2], x0.w + acc[r][3]};
                        *(f32x4*)(XA + off + 4) = (f32x4){x1.x + acc[r][4], x1.y + acc[r][5], x1.z + acc[r][6], x1.w + acc[r][7]}; }
                }
                          }
            }
}
            SEAM(12);
        }
    }
#undef IN
#undef SEAM
}

extern "C" void kernel_launch(void* const* d_in, const int* in_sizes, int n_in, void* d_out, int out_size, void* d_ws, size_t ws_size, hipStream_t stream) {
    static int grid = 0;
    if (grid == 0) {
        if (n_in != 17 || ws_size < WS_END) { fprintf(stderr, "kernel_launch: unexpected n_in %d / ws %zu\n", n_in, ws_size); grid = -1; return; }
        int dev = 0, cus = 0, per_cu = 0;
        hipGetDevice(&dev); hipDeviceGetAttribute(&cus, hipDeviceAttributeMultiprocessorCount, dev);
        if (hipFuncSetAttribute((const void*)mega, hipFuncAttributeMaxDynamicSharedMemorySize, LDS_BYTES) != hipSuccess) { fprintf(stderr, "kernel_launch: hipFuncSetAttribute failed\n"); grid = -1; return; }
        if (hipOccupancyMaxActiveBlocksPerMultiprocessor(&per_cu, (const void*)mega, NTHR, LDS_BYTES) != hipSuccess || per_cu < 1) { fprintf(stderr, "kernel_launch: occupancy query says %d\n", per_cu); }
        (void)hipGetLastError();
        grid = cus;
    }
    if (grid < 0) return;
    hipMemsetAsync((char*)d_ws + WS_CTL, 0, CTL_BYTES, stream);
    Args a{};
    for (int i = 0; i < 17; ++i) a.in[i] = (const float*)d_in[i];
    a.out = (float*)d_out; a.ws = (unsigned char*)d_ws; a.ph_lo = 0; a.ph_hi = 17;
    hipLaunchKernelGGL(mega, dim3(grid), dim3(NTHR), LDS_BYTES, stream, a);
}
```

```cpp
#include <hip/hip_runtime.h>
#include <cstdio>
#include <cstdint>

#define GAS __attribute__((address_space(1)))
#define LAS __attribute__((address_space(3)))
typedef unsigned short bf16;
typedef float f32x4 __attribute__((ext_vector_type(4)));
typedef unsigned u32x4 __attribute__((ext_vector_type(4)));
typedef unsigned u32x2 __attribute__((ext_vector_type(2)));
typedef short bf16x8 __attribute__((ext_vector_type(8)));
typedef short s16x4 __attribute__((ext_vector_type(4)));

constexpr int BATCH = 8, SEQ = 2048, DM = 2048, NTOK = BATCH * SEQ;
constexpr int NHEAD = 12, HD = 128, AW = 1536, QKVW = 4608;
constexpr int NE = 64, DE = 512, NGRP = 8;
constexpr int FG = 8, FC = 256;
constexpr float EPS = 1e-6f;
constexpr int NWAVES = 8, NTHR = 512;
constexpr int SLOT_CAP = 49152;

constexpr size_t MiB = 1u << 20;
constexpr size_t WS_CTL = 0, CTL_BYTES = 98304;
constexpr size_t WS_WQKVT = 2 * MiB;
constexpr size_t WS_WOT = 22 * MiB;
constexpr size_t WS_WINB = 30 * MiB;
constexpr size_t WS_WPT = 40 * MiB;
constexpr size_t WS_W2T = 50 * MiB;
constexpr size_t WS_HART = 60 * MiB;
constexpr size_t WS_TT = 70 * MiB;
constexpr size_t WS_ROPE = 71 * MiB;
constexpr size_t WS_RTAB = 72 * MiB;
constexpr size_t WS_SLOT = 75 * MiB;
constexpr size_t WS_SLOTW = 76 * MiB;
constexpr size_t WS_LSE = 77 * MiB;
constexpr size_t WS_SSQ = 78 * MiB;
constexpr size_t WS_TOKL = 80 * MiB;
constexpr size_t WS_H = 96 * MiB;
constexpr size_t WS_QKV = 160 * MiB;
constexpr size_t WS_O = 304 * MiB;
constexpr size_t WS_MIX = 352 * MiB;
constexpr size_t WS_XA = 400 * MiB;
constexpr size_t WS_XB = 528 * MiB;
constexpr size_t WS_A = 352 * MiB;
constexpr size_t WS_Y = 160 * MiB;
constexpr size_t WS_VSYM = 160 * MiB;
constexpr size_t WS_Z = 224 * MiB;
constexpr size_t WS_END = 656 * MiB;
constexpr int CW_BAR = 4096;
constexpr int CW_CNT = 16384;
constexpr int CW_DONE = 8192;
constexpr int CW_Q = 22528;
constexpr int CW_RANK = 20480;

#ifndef FASTMASK_V
#define FASTMASK_V 0x1ff
#endif
constexpr int FASTMASK = FASTMASK_V;
#ifndef PROBE_SAMEW
#define PROBE_SAMEW 0
#endif
#ifndef REPMASK
#define REPMASK 0
#endif
constexpr int LDS_BYTES = 147456;
constexpr int MISC_OFF = 139264;

__device__ __forceinline__ float bf2f(bf16 v) { return __uint_as_float(((unsigned)v) << 16); }
__device__ __forceinline__ unsigned f2bf(float f) { unsigned u = __float_as_uint(f); return (u + 0x7fffu + ((u >> 16) & 1u)) >> 16; }
__device__ __forceinline__ unsigned pk2(float lo, float hi) { return f2bf(lo) | (f2bf(hi) << 16); }
template <int O> __device__ __forceinline__ float xshfl(float v) { return __int_as_float(__builtin_amdgcn_ds_swizzle(__float_as_int(v), (O << 10) | 0x1F)); }
__device__ __forceinline__ float half_sum(float v) { const auto r = __builtin_amdgcn_permlane32_swap(__float_as_uint(v), __float_as_uint(v), false, false); return __uint_as_float(r[0]) + __uint_as_float(r[1]); }
__device__ __forceinline__ float half_max(float v) { const auto r = __builtin_amdgcn_permlane32_swap(__float_as_uint(v), __float_as_uint(v), false, false); return fmaxf(__uint_as_float(r[0]), __uint_as_float(r[1])); }
__device__ __forceinline__ float wave_sum(float v) { v += xshfl<1>(v); v += xshfl<2>(v); v += xshfl<4>(v); v += xshfl<8>(v); v += xshfl<16>(v); return half_sum(v); }
__device__ __forceinline__ float wave_max(float v) { v = fmaxf(v, xshfl<1>(v)); v = fmaxf(v, xshfl<2>(v)); v = fmaxf(v, xshfl<4>(v)); v = fmaxf(v, xshfl<8>(v)); v = fmaxf(v, xshfl<16>(v)); return half_max(v); }

#define XB_TMO      128
#define XB_XCNT(j)  (256  + 64 * (j))
#define XB_XSUB(j)  (1280 + 64 * (j))
#define XB_XGEN(j)  (2304 + 64 * (j))
#define XB_TOP      3328
#define XB_TOPGEN   3392
#define XCD_BAR_WORDS 3456
#define XB_SPIN_CAP (1u << 22)

__device__ __forceinline__ unsigned xb_ld(unsigned* p)              { return __hip_atomic_load(p, __ATOMIC_RELAXED, __HIP_MEMORY_SCOPE_AGENT); }
__device__ __forceinline__ unsigned xb_add(unsigned* p, unsigned v) { return __hip_atomic_fetch_add(p, v, __ATOMIC_RELAXED, __HIP_MEMORY_SCOPE_AGENT); }
__device__ __forceinline__ unsigned xb_xcc_id() { return (unsigned)__builtin_amdgcn_s_getreg((3 << 11) | 20) & 0xFu; }
#define XB_SPIN(cond, bar) do { unsigned _sp = 0; while (cond) { __builtin_amdgcn_s_sleep(1); \
    if ((++_sp & 255u) == 0u) { if (xb_ld(&(bar)[XB_TMO])) break; if (_sp > XB_SPIN_CAP) { atomicAdd(&(bar)[XB_TMO], 1u); break; } } } } while (0)

__device__ __forceinline__ void xb_ld16(unsigned* bar, unsigned (&c)[16]) {
    const unsigned* p = bar + XB_XCNT(0);
    asm volatile(
        "global_load_dword %0, %16, off sc1\n\t"              "global_load_dword %1, %16, off offset:256 sc1\n\t"
        "global_load_dword %2, %16, off offset:512 sc1\n\t"   "global_load_dword %3, %16, off offset:768 sc1\n\t"
        "global_load_dword %4, %16, off offset:1024 sc1\n\t"  "global_load_dword %5, %16, off offset:1280 sc1\n\t"
        "global_load_dword %6, %16, off offset:1536 sc1\n\t"  "global_load_dword %7, %16, off offset:1792 sc1\n\t"
        "global_load_dword %8, %16, off offset:2048 sc1\n\t"  "global_load_dword %9, %16, off offset:2304 sc1\n\t"
        "global_load_dword %10, %16, off offset:2560 sc1\n\t" "global_load_dword %11, %16, off offset:2816 sc1\n\t"
        "global_load_dword %12, %16, off offset:3072 sc1\n\t" "global_load_dword %13, %16, off offset:3328 sc1\n\t"
        "global_load_dword %14, %16, off offset:3584 sc1\n\t" "global_load_dword %15, %16, off offset:3840 sc1\n\t"
        "s_waitcnt vmcnt(0)"
        : "=&v"(c[0]), "=&v"(c[1]), "=&v"(c[2]), "=&v"(c[3]), "=&v"(c[4]), "=&v"(c[5]), "=&v"(c[6]), "=&v"(c[7]),
          "=&v"(c[8]), "=&v"(c[9]), "=&v"(c[10]), "=&v"(c[11]), "=&v"(c[12]), "=&v"(c[13]), "=&v"(c[14]), "=&v"(c[15])
        : "v"(p) : "memory");
}
struct XcdBarrier { unsigned* bar; unsigned x; volatile LAS unsigned* st; };

__device__ __forceinline__ XcdBarrier xcd_barrier_post(unsigned* bar, volatile LAS unsigned* st, bool leader) {
    XcdBarrier b; b.bar = bar; b.x = xb_xcc_id(); b.st = st;
    if (leader) (void)xb_add(&bar[XB_XCNT(b.x)], 1u);
    return b;
}
__device__ __forceinline__ void xcd_barrier_complete(unsigned* bar, unsigned x, unsigned& nloc, unsigned& nx) {
    const unsigned G = gridDim.x * gridDim.y * gridDim.z;
    unsigned sum, cnt, mine, sp = 0u;
    for (;;) {
        sum = 0u; cnt = 0u; mine = 0u;
        unsigned c[16]; xb_ld16(bar, c);
#pragma unroll
        for (unsigned j = 0; j < 16; ++j) { sum += c[j]; cnt += (c[j] > 0u) ? 1u : 0u; mine = (j == x) ? c[j] : mine; }
        if (sum == G) break;
        __builtin_amdgcn_s_sleep(1);
        if ((++sp & 255u) == 0u) { if (xb_ld(&bar[XB_TMO])) break; if (sp > XB_SPIN_CAP) { atomicAdd(&bar[XB_TMO], 1u); break; } }
    }
    nloc = mine > 0u ? mine : 1u; nx = cnt > 0u ? cnt : 1u;
}
__device__ __forceinline__ void xcd_barrier(const XcdBarrier& b, bool leader) {
    asm volatile("s_waitcnt vmcnt(0)" ::: "memory");
    __syncthreads();
    if (leader) {
        unsigned* bar = b.bar;
        __builtin_amdgcn_s_waitcnt(0);
        unsigned nloc = b.st[0], nx = b.st[1];
        if (nloc == 0u) { xcd_barrier_complete(bar, b.x, nloc, nx); b.st[0] = nloc; b.st[1] = nx; }
        const unsigned old = xb_add(&bar[XB_XSUB(b.x)], 1u);
        const unsigned gen = old / nloc;
        if (old + 1u == (gen + 1u) * nloc) {
            __builtin_amdgcn_fence(__ATOMIC_RELEASE, "agent");
            asm volatile("s_waitcnt vmcnt(0)" ::: "memory");
            const unsigned og = xb_add(&bar[XB_TOP], 1u);
            const unsigned tg = og / nx;
            if (og + 1u == (tg + 1u) * nx) xb_add(&bar[XB_TOPGEN], 1u);
            else XB_SPIN(xb_ld(&bar[XB_TOPGEN]) == tg, bar);
            __builtin_amdgcn_fence(__ATOMIC_ACQUIRE, "agent");
            xb_add(&bar[XB_XGEN(b.x)], 1u);
            asm volatile("s_waitcnt vmcnt(0)" ::: "memory");
        } else {
            XB_SPIN(xb_ld(&bar[XB_XGEN(b.x)]) == gen, bar);
            __builtin_amdgcn_fence(__ATOMIC_ACQUIRE, "agent");
            asm volatile("s_waitcnt vmcnt(0)" ::: "memory");
        }
    }
    __syncthreads();
}

struct Args { const float* in[17]; float* out; unsigned char* ws; int ph_lo, ph_hi; };

struct Frame {
    LAS unsigned char* lds;
    int tid, lane, wave, G, bid;
    float* out; unsigned char* ws;
};

template <class SF>
__device__ __forceinline__ void transpose_item(SF src4, int N, bf16* dst, int Kd, LAS float* scr, int item, int lane) {
    const int nblk = N / 64, kb = item / nblk, nb = item % nblk, k0 = 64 * kb, n0 = 64 * nb;
    f32x4 v[16];
#pragma unroll
    for (int i = 0; i < 16; ++i) v[i] = src4(k0 + (lane >> 4) + 4 * i, n0 + 4 * (lane & 15));
#pragma unroll
    for (int i = 0; i < 16; ++i) *(LAS f32x4*)(scr + ((lane >> 4) + 4 * i) * 68 + 4 * (lane & 15)) = v[i];
    asm volatile("s_waitcnt lgkmcnt(0)" ::: "memory");
    const int c = lane & 7;
#pragma unroll
    for (int j = 0; j < 8; ++j) { const int n = (lane >> 3) + 8 * j; const LAS float* s = scr + (8 * c) * 68 + n;
        u32x4 o; o.x = pk2(s[0 * 68], s[1 * 68]); o.y = pk2(s[2 * 68], s[3 * 68]); o.z = pk2(s[4 * 68], s[5 * 68]); o.w = pk2(s[6 * 68], s[7 * 68]);
        *(u32x4*)(dst + (size_t)(n0 + n) * Kd + k0 + 8 * c) = o; }
    asm volatile("s_waitcnt lgkmcnt(0)" ::: "memory");
}

__device__ __forceinline__ void rms_row_to_bf16(const float* xrow, const float* g, bf16* orow, int lane) {
    const f32x4* xr = (const f32x4*)xrow + lane; const f32x4* gr = (const f32x4*)g + lane;
    f32x4 v[8]; float s = 0.f;
#pragma unroll
    for (int j = 0; j < 8; ++j) { v[j] = xr[64 * j]; s += (v[j].x * v[j].x + v[j].y * v[j].y) + (v[j].z * v[j].z + v[j].w * v[j].w); }
    const float rstd = 1.0f / sqrtf(wave_sum(s) * (1.f / DM) + EPS);
    u32x2* o8 = (u32x2*)orow + lane;
#pragma unroll
    for (int j = 0; j < 8; ++j) { const f32x4 gg = gr[64 * j]; u32x2 w; w.x = pk2(v[j].x * rstd * gg.x, v[j].y * rstd * gg.y); w.y = pk2(v[j].z * rstd * gg.z, v[j].w * rstd * gg.w); o8[64 * j] = w; }
}

template <bool A_KC, bool B_KC, class AF, class BF>
__device__ __forceinline__ void ngemm_tile(LAS float* sm, int K, AF af, BF bf, float (&acc)[4][8]) {
    LAS float* As = sm; LAS float* Bs = sm + 16 * 132;
    const int tid = threadIdx.x, ty = tid >> 4, tx = tid & 15;
#pragma unroll
    for (int r = 0; r < 4; ++r)
#pragma unroll
        for (int c = 0; c < 8; ++c) acc[r][c] = 0.f;
    for (int k0 = 0; k0 < K; k0 += 16) {
#pragma unroll
        for (int q = 0; q < 4; ++q) {
            const int e = tid + 512 * q;
            { int k, i; if (A_KC) { k = e & 15; i = e >> 4; } else { i = e & 127; k = e >> 7; } As[k * 132 + i] = af(i, k0 + k); }
            { int k, j; if (B_KC) { k = e & 15; j = e >> 4; } else { j = e & 127; k = e >> 7; } Bs[k * 132 + j] = bf(k0 + k, j); }
        }
        __syncthreads();
#pragma unroll 2
        for (int k = 0; k < 16; ++k) {
            float a[4], b[8];
#pragma unroll
            for (int r = 0; r < 4; ++r) a[r] = As[k * 132 + ty * 4 + r];
#pragma unroll
            for (int c = 0; c < 8; ++c) b[c] = Bs[k * 132 + tx * 8 + c];
#pragma unroll
            for (int r = 0; r < 4; ++r)
#pragma unroll
                for (int c = 0; c < 8; ++c) acc[r][c] += a[r] * b[c];
        }
        __syncthreads();
    }
}

typedef float f32x2 __attribute__((ext_vector_type(2)));
typedef __bf16 b16x2 __attribute__((ext_vector_type(2)));
__device__ __forceinline__ f32x4 unpk4(u32x2 v) { return (f32x4){__uint_as_float(v.x << 16), __uint_as_float(v.x & 0xffff0000u), __uint_as_float(v.y << 16), __uint_as_float(v.y & 0xffff0000u)}; }
__device__ __forceinline__ unsigned cvtpk(float a, float b) { f32x2 v = {a, b}; b16x2 r = __builtin_convertvector(v, b16x2); return __builtin_bit_cast(unsigned, r); }
__device__ __forceinline__ int kc_byte(int r, int c) { const int st = (r >> 4) * 2 + (c >> 5), ob = (r & 15) * 64 + (c & 31) * 2; return st * 1024 + (ob ^ (((ob >> 9) & 1) << 5)); }
__device__ __forceinline__ void kc_rc(int b, int& R, int& C) { const int st = b >> 10, sb = b & 1023, swz = sb ^ (((sb >> 9) & 1) << 5); R = (st >> 1) * 16 + (swz >> 6); C = (st & 1) * 32 + ((swz & 63) >> 1); }
__device__ __forceinline__ int kn_addr(int row, int colbyte) { return 544 * row + (colbyte ^ (((row >> 3) & 1) << 7)); }
constexpr int STAGE_BYTES = 32768 + 34816;

struct KcLoader {
    const char* base; unsigned off[4]; u32x4 s[4];
    template <class RO> __device__ __forceinline__ void init(const bf16* base_, RO rowoff, int tid) {
        base = (const char*)base_;
#pragma unroll
        for (int i = 0; i < 4; ++i) { const int R = (tid >> 3) + 64 * i; off[i] = (unsigned)(rowoff(R) + (tid & 7) * 8) * 2u; }
    }
    __device__ __forceinline__ void issue(int kt) {
#pragma unroll
        for (int i = 0; i < 4; ++i) s[i] = *(const u32x4*)(base + (size_t)(off[i] + (unsigned)kt * 128u));
    }
    __device__ __forceinline__ void write(LAS unsigned char* dst, int tid) {
        const int r0 = tid >> 3, c = tid & 7;
#pragma unroll
        for (int i = 0; i < 4; ++i) *(LAS u32x4*)(dst + (r0 + 64 * i) * 128 + ((c ^ (r0 & 7)) << 4)) = s[i];
    }
};
struct KnF32Loader {
    const float* cp; int ldb; f32x4 s[8];
    __device__ __forceinline__ void init(const float* cp_, int ldb_) { cp = cp_; ldb = ldb_; }
    __device__ __forceinline__ void issue(int kt) {
#pragma unroll
        for (int i = 0; i < 8; ++i) s[i] = *(const f32x4*)(cp + (size_t)((kt * 64 + i * 8) * ldb));
    }
    __device__ __forceinline__ void write(LAS unsigned char* dst, int wid, int lane) {
#pragma unroll
        for (int i = 0; i < 8; ++i) { const int row = i * 8 + wid; u32x2 w; w.x = cvtpk(s[i].x, s[i].y); w.y = cvtpk(s[i].z, s[i].w);
            *(LAS u32x2*)(dst + kn_addr(row, 8 * lane)) = w; }
    }
};
struct KnBf16Loader {
    const char* base; unsigned off; int ldb; u32x4 s[4];
    __device__ __forceinline__ void init(const bf16* base_, unsigned off_elems, int ldb_) { base = (const char*)base_; off = off_elems * 2u; ldb = ldb_; }
    __device__ __forceinline__ void issue(int kt) {
#pragma unroll
        for (int i = 0; i < 4; ++i) s[i] = *(const u32x4*)(base + (size_t)(off + (unsigned)((kt * 64 + i * 16) * ldb) * 2u));
    }
    __device__ __forceinline__ void write(LAS unsigned char* dst, int wid, int lane) {
#pragma unroll
        for (int i = 0; i < 4; ++i) { const int row = i * 16 + wid * 2 + (lane >> 5); *(LAS u32x4*)(dst + kn_addr(row, 16 * (lane & 31))) = s[i]; }
    }
};

template <int ROWMAP, bool B_KN, class AL, class BL>
__device__ __forceinline__ void fgemm_unit(LAS unsigned char* lds, AL& al, BL& bl, int nt, f32x4 (&acc)[8][4], int tid) {
    const int wid = __builtin_amdgcn_readfirstlane(tid >> 6), lane = tid & 63, wr = wid >> 2, wc = wid & 3, fr = lane & 15, fq = lane >> 4;
#pragma unroll
    for (int m = 0; m < 8; ++m)
#pragma unroll
        for (int n = 0; n < 4; ++n) acc[m][n] = (f32x4){0.f, 0.f, 0.f, 0.f};
#define BWRITE(p) do { if constexpr (B_KN) bl.write((p), wid, lane); else bl.write((p), tid); } while (0)
    al.issue(0); bl.issue(0);
    al.write(lds, tid); BWRITE(lds + 32768);
    al.issue(1); bl.issue(1);
    __syncthreads();
    const int xk0 = ((fq ^ (fr & 7)) << 4), xk1 = (((4 + fq) ^ (fr & 7)) << 4);
    int aoff[2];
    if (ROWMAP == 0) { aoff[0] = (wr * 128 + fr) * 128; aoff[1] = aoff[0] + 4 * 2048; }
    else { aoff[0] = (wr * 64 + fr) * 128; aoff[1] = (128 + wr * 64 + fr) * 128; }
    const int boff = (wc * 64 + fr) * 128;
    const int g = lane >> 4, q = (lane & 15) >> 2, p = lane & 3;
    const int troff = (8 * g + q) * 544 + ((wc * 128 + 8 * p) ^ ((g & 1) << 7));
#pragma unroll 1
    for (int t = 0; t < nt; ++t) {
        const int cur = t & 1;
        LAS unsigned char* SA = lds + cur * STAGE_BYTES; LAS unsigned char* SBp = SA + 32768;
        if (t + 1 < nt) { al.write(lds + (cur ^ 1) * STAGE_BYTES, tid); BWRITE(lds + (cur ^ 1) * STAGE_BYTES + 32768); }
        if (t + 2 < nt) { al.issue(t + 2); bl.issue(t + 2); }
        __builtin_amdgcn_sched_barrier(0);
#pragma unroll
        for (int ks = 0; ks < 2; ++ks) {
            bf16x8 At[8], Bf[4];
#pragma unroll
            for (int m = 0; m < 8; ++m) At[m] = *(const LAS bf16x8*)(SA + aoff[m >> 2] + (m & 3) * 2048 + (ks ? xk1 : xk0));
            if (!B_KN) {
#pragma unroll
                for (int n = 0; n < 4; ++n) Bf[n] = *(const LAS bf16x8*)(SBp + boff + n * 2048 + (ks ? xk1 : xk0));
            } else {
#pragma unroll
                for (int n = 0; n < 4; ++n) {
                    s16x4 h[2];
#pragma unroll
                    for (int tt = 0; tt < 2; ++tt) h[tt] = __builtin_amdgcn_ds_read_tr16_b64_v4i16((LAS s16x4*)(SBp + troff + n * 32 + (32 * ks + 4 * tt) * 544));
                    Bf[n] = __builtin_shufflevector(h[0], h[1], 0, 1, 2, 3, 4, 5, 6, 7);
                }
            }
#pragma unroll
            for (int m = 0; m < 8; ++m)
#pragma unroll
                for (int n = 0; n < 4; ++n) acc[m][n] = __builtin_amdgcn_mfma_f32_16x16x32_bf16(Bf[n], At[m], acc[m][n], 0, 0, 0);
            __builtin_amdgcn_sched_barrier(0);
        }
        __syncthreads();
    }
}

struct GldsKc { static constexpr int AMODE = 0;
    const char* base; unsigned off[4];
    template <class RO> __device__ __forceinline__ void init(const bf16* base_, RO rowoff, int tid) {
        base = (const char*)base_;
#pragma unroll
        for (int i = 0; i < 4; ++i) { const int R = (tid >> 3) + 64 * i; off[i] = (unsigned)(rowoff(R) + (((tid & 7) ^ ((tid >> 3) & 7)) * 8)) * 2u; }
    }
    template <class RO> __device__ __forceinline__ void init_i(const bf16* base_, RO rowoff, int tid) {
        base = (const char*)base_;
#pragma unroll
        for (int i = 0; i < 4; ++i) { const int R = (tid >> 3) + 64 * i; off[i] = (unsigned)(rowoff(R, i) + (((tid & 7) ^ ((tid >> 3) & 7)) * 8)) * 2u; }
    }
    __device__ __forceinline__ void stage(LAS unsigned char* dst, int kt, int wid) {
#pragma unroll
        for (int i = 0; i < 4; ++i) __builtin_amdgcn_global_load_lds((const unsigned*)(base + (size_t)(off[i] + (unsigned)kt * 128u)), (LAS unsigned*)(dst + wid * 1024 + i * 8192), 16, 0, 0);
    }
};
struct MixA { static constexpr int AMODE = 1;
    const char* ob; const float* lse; unsigned off[4], lo[4]; u32x4 s[4]; float l[4][3], av[4]; int gsel;
    __device__ __forceinline__ void init(const bf16* O_, const float* lse_, int row0, int tid) { ob = (const char*)O_; lse = lse_; gsel = 0;
#pragma unroll
        for (int i = 0; i < 4; ++i) { const int R = row0 + (tid >> 3) + 64 * i; off[i] = (unsigned)(R * AW + (((tid & 7) ^ ((tid >> 3) & 7)) * 8)) * 2u; lo[i] = (unsigned)(R * NHEAD) * 4u; } }
    __device__ __forceinline__ void issue(int kt) {
#pragma unroll
        for (int i = 0; i < 4; ++i) s[i] = *(const u32x4*)(ob + (size_t)(off[i] + (unsigned)kt * 128u));
        if ((kt & 1) == 0) { const int h = kt >> 1, hg = h & 3; gsel = h >> 2;
#pragma unroll
            for (int i = 0; i < 4; ++i) { const float* p = (const float*)((const char*)lse + lo[i]) + hg; l[i][0] = p[0]; l[i][1] = p[4]; l[i][2] = p[8]; } }
    }
    __device__ __forceinline__ void write(LAS unsigned char* dst, int tid, int kt) {
        if ((kt & 1) == 0) {
#pragma unroll
            for (int i = 0; i < 4; ++i) { const float m = fmaxf(l[i][0], fmaxf(l[i][1], l[i][2])); const float e0 = __expf(l[i][0] - m), e1 = __expf(l[i][1] - m), e2 = __expf(l[i][2] - m);
                av[i] = (gsel == 0 ? e0 : (gsel == 1 ? e1 : e2)) / (e0 + e1 + e2); } }
#pragma unroll
        for (int i = 0; i < 4; ++i) { const float a = av[i]; const u32x4 v = s[i]; u32x4 o;
            o.x = cvtpk(__uint_as_float(v.x << 16) * a, __uint_as_float(v.x & 0xffff0000u) * a); o.y = cvtpk(__uint_as_float(v.y << 16) * a, __uint_as_float(v.y & 0xffff0000u) * a);
            o.z = cvtpk(__uint_as_float(v.z << 16) * a, __uint_as_float(v.z & 0xffff0000u) * a); o.w = cvtpk(__uint_as_float(v.w << 16) * a, __uint_as_float(v.w & 0xffff0000u) * a);
            *(LAS u32x4*)(dst + tid * 16 + i * 8192) = o; }
    }
};
template <int ROWMAP, int BMODE, class BL, class AL>
__device__ __forceinline__ void fgemm2(LAS unsigned char* lds, AL& al, BL& bl, int nt, f32x4 (&acc)[8][4], int tid) {
    const int wid = __builtin_amdgcn_readfirstlane(tid >> 6), lane = tid & 63, wr = wid >> 2, wc = wid & 3, fr = lane & 15, fq = lane >> 4;
#pragma unroll
    for (int m = 0; m < 8; ++m)
#pragma unroll
        for (int n = 0; n < 4; ++n) acc[m][n] = (f32x4){0.f, 0.f, 0.f, 0.f};
    if constexpr (AL::AMODE == 0) al.stage(lds, 0, wid); else { al.issue(0); al.write(lds, tid, 0); if (nt > 1) al.issue(1); }
    if constexpr (BMODE == 0) bl.stage(lds + 32768, 0, wid);
    else { bl.issue(0); bl.write(lds + 32768, wid, lane); if (nt > 1) bl.issue(1); }
    asm volatile("s_waitcnt vmcnt(0)" ::: "memory");
    __syncthreads();
    const int xk0 = ((fq ^ (fr & 7)) << 4), xk1 = (((4 + fq) ^ (fr & 7)) << 4);
    int aoff[2];
    if (ROWMAP == 0) { aoff[0] = (wr * 128 + fr) * 128; aoff[1] = aoff[0] + 4 * 2048; }
    else { aoff[0] = (wr * 64 + fr) * 128; aoff[1] = (128 + wr * 64 + fr) * 128; }
    const int boff = (wc * 64 + fr) * 128;
    const int g = lane >> 4, q = (lane & 15) >> 2, p = lane & 3;
    const int troff = (8 * g + q) * 544 + ((wc * 128 + 8 * p) ^ ((g & 1) << 7));
#define DSR128(dst, addr, off) asm volatile("ds_read_b128 %0, %1 offset:%2" : "=v"(dst) : "v"(addr), "n"(off) : "memory")
#define DSRTR(dst, addr, off) asm volatile("ds_read_b64_tr_b16 %0, %1 offset:%2" : "=v"(dst) : "v"(addr), "n"(off) : "memory")
#define LGKM(n) do { asm volatile("s_waitcnt lgkmcnt(%0)" :: "n"(n) : "memory"); __builtin_amdgcn_sched_barrier(0); } while (0)
#define F2_LDB4(Bv, Bh0, Bh1, ks) do { if constexpr (BMODE == 0) { DSR128(Bv[0], (ks) ? bb1 : bb0, 0); DSR128(Bv[1], (ks) ? bb1 : bb0, 2048); DSR128(Bv[2], (ks) ? bb1 : bb0, 4096); DSR128(Bv[3], (ks) ? bb1 : bb0, 6144); } \
        else { DSRTR(Bh0[0], bt, 0 + (32 * (ks)) * 544); DSRTR(Bh1[0], bt, 0 + (32 * (ks) + 4) * 544); DSRTR(Bh0[1], bt, 32 + (32 * (ks)) * 544); DSRTR(Bh1[1], bt, 32 + (32 * (ks) + 4) * 544); \
               DSRTR(Bh0[2], bt, 64 + (32 * (ks)) * 544); DSRTR(Bh1[2], bt, 64 + (32 * (ks) + 4) * 544); DSRTR(Bh0[3], bt, 96 + (32 * (ks)) * 544); DSRTR(Bh1[3], bt, 96 + (32 * (ks) + 4) * 544); } } while (0)
#define F2_BFRAG(Bv, Bh0, Bh1, n) (BMODE == 0 ? Bv[n] : __builtin_shufflevector(Bh0[n], Bh1[n], 0, 1, 2, 3, 4, 5, 6, 7))
#define F2_MMA8(mA, Aa, Ab, Bv, Bh0, Bh1) do { _Pragma("unroll") for (int n = 0; n < 4; ++n) acc[mA][n] = __builtin_amdgcn_mfma_f32_16x16x32_bf16(F2_BFRAG(Bv, Bh0, Bh1, n), Aa, acc[mA][n], 0, 0, 0); \
        _Pragma("unroll") for (int n = 0; n < 4; ++n) acc[mA + 1][n] = __builtin_amdgcn_mfma_f32_16x16x32_bf16(F2_BFRAG(Bv, Bh0, Bh1, n), Ab, acc[mA + 1][n], 0, 0, 0); } while (0)
    constexpr int NB = (BMODE == 0) ? 4 : 8;
    bf16x8 Bc[4], Bn[4]; s16x4 Bc0[4], Bc1[4], Bn0[4], Bn1[4]; bf16x8 A0, A1, A2, A3;
    (void)Bc; (void)Bn; (void)Bc0; (void)Bc1; (void)Bn0; (void)Bn1;
    const unsigned sa0 = (unsigned)(size_t)lds;
#define F2_PRODUCE(tt) do { LAS unsigned char* st_ = lds + ((tt) & 1) * STAGE_BYTES; \
        if constexpr (BMODE != 0) bl.write(st_ + 32768, wid, lane); \
        if constexpr (AL::AMODE == 0) al.stage(st_, (tt), wid); else { al.write(st_, tid, (tt)); if ((tt) + 1 < nt) al.issue((tt) + 1); } \
        if constexpr (BMODE == 0) bl.stage(st_ + 32768, (tt), wid); \
        if constexpr (BMODE != 0) { if ((tt) + 1 < nt) bl.issue((tt) + 1); } } while (0)
#define F2_FIRST(cur_) do { const unsigned sa_ = sa0 + (cur_) * STAGE_BYTES; const unsigned bb0_ = sa_ + 32768 + boff + xk0, bt_ = sa_ + 32768 + troff; (void)bb0_; (void)bt_; \
        if constexpr (BMODE == 0) { DSR128(Bc[0], bb0_, 0); DSR128(Bc[1], bb0_, 2048); DSR128(Bc[2], bb0_, 4096); DSR128(Bc[3], bb0_, 6144); } \
        else { DSRTR(Bc0[0], bt_, 0); DSRTR(Bc1[0], bt_, 4 * 544); DSRTR(Bc0[1], bt_, 32); DSRTR(Bc1[1], bt_, 32 + 4 * 544); DSRTR(Bc0[2], bt_, 64); DSRTR(Bc1[2], bt_, 64 + 4 * 544); DSRTR(Bc0[3], bt_, 96); DSRTR(Bc1[3], bt_, 96 + 4 * 544); } \
        DSR128(A0, sa_ + aoff[0] + xk0, 0); DSR128(A1, sa_ + aoff[0] + xk0, 2048); } while (0)
    if (nt > 1) F2_PRODUCE(1);
    __builtin_amdgcn_sched_barrier(0);
    F2_FIRST(0);
#pragma unroll 1
    for (int t = 0; t < nt; ++t) {
        const int cur = t & 1;
        const unsigned sa = sa0 + cur * STAGE_BYTES, sb = sa + 32768;
        const unsigned a00 = sa + aoff[0] + xk0, a01 = sa + aoff[0] + xk1, a10 = sa + aoff[1] + xk0, a11 = sa + aoff[1] + xk1;
        const unsigned bb1 = sb + boff + xk1, bt = sb + troff; (void)bb1; (void)bt;
        DSR128(A2, a00, 4096); DSR128(A3, a00, 6144); LGKM(2); F2_MMA8(0, A0, A1, Bc, Bc0, Bc1);
        DSR128(A0, a10, 0); DSR128(A1, a10, 2048); LGKM(2); F2_MMA8(2, A2, A3, Bc, Bc0, Bc1);
        DSR128(A2, a10, 4096); DSR128(A3, a10, 6144); LGKM(2); F2_MMA8(4, A0, A1, Bc, Bc0, Bc1);
        if constexpr (BMODE == 0) { DSR128(Bn[0], bb1, 0); DSR128(Bn[1], bb1, 2048); DSR128(Bn[2], bb1, 4096); DSR128(Bn[3], bb1, 6144); }
        else { DSRTR(Bn0[0], bt, 32 * 544); DSRTR(Bn1[0], bt, 36 * 544); DSRTR(Bn0[1], bt, 32 + 32 * 544); DSRTR(Bn1[1], bt, 32 + 36 * 544); DSRTR(Bn0[2], bt, 64 + 32 * 544); DSRTR(Bn1[2], bt, 64 + 36 * 544); DSRTR(Bn0[3], bt, 96 + 32 * 544); DSRTR(Bn1[3], bt, 96 + 36 * 544); }
        DSR128(A0, a01, 0); DSR128(A1, a01, 2048); LGKM(NB + 2); F2_MMA8(6, A2, A3, Bc, Bc0, Bc1);
        DSR128(A2, a01, 4096); DSR128(A3, a01, 6144); LGKM(2); F2_MMA8(0, A0, A1, Bn, Bn0, Bn1);
        DSR128(A0, a11, 0); DSR128(A1, a11, 2048); LGKM(2); F2_MMA8(2, A2, A3, Bn, Bn0, Bn1);
        DSR128(A2, a11, 4096); DSR128(A3, a11, 6144); LGKM(2); F2_MMA8(4, A0, A1, Bn, Bn0, Bn1);
        LGKM(0);
        if (t + 1 < nt) {
            asm volatile("s_waitcnt vmcnt(0)" ::: "memory");
            __syncthreads();
            if (t + 2 < nt) F2_PRODUCE(t + 2);
            __builtin_amdgcn_sched_barrier(0);
            F2_FIRST(cur ^ 1);
        }
        F2_MMA8(6, A2, A3, Bn, Bn0, Bn1);
    }
    __syncthreads();
#undef F2_PRODUCE
#undef F2_FIRST
#undef DSR128
#undef DSRTR
#undef LGKM
#undef F2_LDB4
#undef F2_BFRAG
#undef F2_MMA8
}


struct MoeTab { int cnt[NE]; int offs[NE]; };
__device__ __forceinline__ void moe_load_tab(LAS int* tab  , const unsigned* cnt_g, int tid) {
    if (tid < NE) tab[tid] = (int)cnt_g[tid];
    __syncthreads();
    if (tid == 0) { int o = 0; for (int e = 0; e < NE; ++e) { tab[NE + e] = o; o += ((tab[e] + 255) >> 8) << 8; } }
    __syncthreads();
}

__global__ void __launch_bounds__(NTHR, 2) mega(Args args) {
    extern __shared__ __attribute__((aligned(16))) unsigned char lds_raw[];
    Frame F;
    F.lds = (LAS unsigned char*)lds_raw;
    const int wave_s = __builtin_amdgcn_readfirstlane((int)threadIdx.x >> 6);
#define MY_TID() ({ unsigned z_ = 0u; asm volatile("" : "+v"(z_)); wave_s * 64 + (int)__builtin_amdgcn_mbcnt_hi(~0u, __builtin_amdgcn_mbcnt_lo(~0u, z_)); })
    F.tid = MY_TID(); F.lane = F.tid & 63; F.wave = wave_s;
    F.G = gridDim.x; F.bid = blockIdx.x;
    F.out = args.out; F.ws = args.ws;
    volatile LAS unsigned* MISC = (volatile LAS unsigned*)(F.lds + MISC_OFF);
    if (F.tid < 64) MISC[F.tid] = 0u;
    __syncthreads();
    unsigned* ctl = (unsigned*)(F.ws + WS_CTL);
    XcdBarrier bar = xcd_barrier_post(ctl + CW_BAR, MISC + 8, F.tid == 0);
    if (F.tid == 0) MISC[16] = xb_add(ctl + CW_RANK + 64 * bar.x, 1u);
    const int lo = args.ph_lo, hi = args.ph_hi;
#define IN(k) (lo <= (k) && (k) < hi)
#define SEAM(k) do { if (IN(k) && IN((k) + 1)) { int t0_ = MY_TID(); asm volatile("" : "+v"(t0_)); xcd_barrier(bar, t0_ == 0); } } while (0)
#define EPI_IDS() int tz_ = MY_TID(); asm volatile("" : "+v"(tz_)); const int wr = (tz_ >> 8) & 1, wc = (tz_ >> 6) & 3, fr = tz_ & 15, fq = (tz_ >> 4) & 3; (void)wr; (void)wc; (void)fr; (void)fq;
#define PHASE_IDS() int tid_ = MY_TID(); asm volatile("" : "+v"(tid_)); const int PT = tid_, PL = tid_ & 63, PW = ({ int w_ = wave_s; asm volatile("" : "+s"(w_)); w_; }); \
    const int gw = F.bid * NWAVES + PW, NGW = F.G * NWAVES, gt = F.bid * NTHR + PT, NGT = F.G * NTHR; (void)gw; (void)NGW; (void)gt; (void)NGT; (void)PL;

    unsigned char* ws = F.ws;
    bf16* WqkvT = (bf16*)(ws + WS_WQKVT); bf16* WoT = (bf16*)(ws + WS_WOT); bf16* WinB = (bf16*)(ws + WS_WINB);
    bf16* WpT = (bf16*)(ws + WS_WPT); bf16* W2T = (bf16*)(ws + WS_W2T); bf16* HART = (bf16*)(ws + WS_HART); bf16* TT = (bf16*)(ws + WS_TT);
    float* ROPE = (float*)(ws + WS_ROPE);
    bf16* Hb = (bf16*)(ws + WS_H); bf16* QKV = (bf16*)(ws + WS_QKV); bf16* Ob = (bf16*)(ws + WS_O); bf16* MIXb = (bf16*)(ws + WS_MIX);
    float* LSE = (float*)(ws + WS_LSE); float* XA = (float*)(ws + WS_XA); float* XB = (float*)(ws + WS_XB);
    bf16* XAh = (bf16*)(ws + WS_XA); bf16* XBh = (bf16*)(ws + WS_XB);
    bf16* Ab = (bf16*)(ws + WS_A); bf16* Yb = (bf16*)(ws + WS_Y); bf16* VSYM = (bf16*)(ws + WS_VSYM); bf16* Zb = (bf16*)(ws + WS_Z);
    int* TOKL = (int*)(ws + WS_TOKL); int* SLOT = (int*)(ws + WS_SLOT); float* SLOTW = (float*)(ws + WS_SLOTW);
    unsigned* CNT = ctl + CW_CNT;
    float* SSQ = (float*)(ws + WS_SSQ);
    float* RSL = (float*)(ws + 84 * MiB);
    float* RS0 = (float*)(ws + WS_LSE + 983040);
    float* RS2 = (float*)(ws + WS_LSE + 917504);


    if (IN(0)) {
        PHASE_IDS();
#pragma unroll 1
        for (int rep_ = 0; rep_ <= ((REPMASK >> 0) & 1); ++rep_) {
        LAS float* scr = (LAS float*)(F.lds + PW * 17408);
        const float* w_qkv = args.in[2]; const float* w_ao = args.in[5]; const float* w_fo = args.in[8];
        constexpr int I_QKV = (DM / 64) * (QKVW / 64), I_AO = (AW / 64) * (DM / 64), I_W2 = (DM / 64) * (DM / 64);
        for (int it = gw; it < I_QKV; it += NGW)
            transpose_item([&](int k, int n) { return *(const f32x4*)(w_qkv + (size_t)k * QKVW + n) * args.in[1][k]; }, QKVW, WqkvT, DM, scr, it, PL);
        { const float* w_fi = args.in[7];
          for (int i0 = gt; i0 < DM * DM / 4; i0 += 8 * NGT) { f32x4 v[8];
#pragma unroll
              for (int q = 0; q < 8; ++q) { const int i = i0 + q * NGT; if (i < DM * DM / 4) v[q] = ((const f32x4*)w_fi)[i]; }
#pragma unroll
              for (int q = 0; q < 8; ++q) { const int i = i0 + q * NGT; if (i < DM * DM / 4) { const float gd = args.in[6][i / (DM / 4)];
                  u32x2 o; o.x = cvtpk(v[q].x * gd, v[q].y * gd); o.y = cvtpk(v[q].z * gd, v[q].w * gd); ((u32x2*)WinB)[i] = o; } } } }
        for (int i = gt; i < 256 * 256; i += NGT) { const int j = i >> 8, c = i & 255; float v;
            if (j <= 128) v = cospif((float)((c * j) & 255) * (1.0f / 128.0f)); else v = sinpif((float)((c * (j - 128)) & 255) * (1.0f / 128.0f));
            TT[i] = (bf16)f2bf(v * (0.5f / 16.0f)); }
        for (int i = gt; i < SEQ * 16; i += NGT) { const int pos = i >> 4, fi = i & 15; const float invf = powf(500000.0f, -(float)fi * (1.0f / 16.0f)); const float ang = (float)pos * invf;
            ROPE[2 * i] = cosf(ang); ROPE[2 * i + 1] = sinf(ang); }
        {
            const float* xin0 = args.in[0]; const f32x4* gr = (const f32x4*)args.in[1] + PL; f32x4 gg[8];
#pragma unroll
            for (int j = 0; j < 8; ++j) gg[j] = gr[64 * j];
            for (int m0 = gw * 4; m0 < NTOK; m0 += NGW * 4) {
                f32x4 v[4][8];
#pragma unroll
                for (int r = 0; r < 4; ++r) { const f32x4* xr = (const f32x4*)(xin0 + (size_t)(m0 + r) * DM) + PL;
#pragma unroll
                    for (int j = 0; j < 8; ++j) v[r][j] = xr[64 * j]; }
#pragma unroll
                for (int r = 0; r < 4; ++r) { float sq = 0.f;
#pragma unroll
                    for (int j = 0; j < 8; ++j) sq += (v[r][j].x * v[r][j].x + v[r][j].y * v[r][j].y) + (v[r][j].z * v[r][j].z + v[r][j].w * v[r][j].w);
                    const float rstd = 1.0f / sqrtf(wave_sum(sq) * (1.f / DM) + EPS); if (PL == 0) RS0[m0 + r] = rstd;
                    u32x2* o8 = (u32x2*)(Hb + (size_t)(m0 + r) * DM) + PL;
#pragma unroll
                    for (int j = 0; j < 8; ++j) { u32x2 w; w.x = cvtpk(v[r][j].x, v[r][j].y); w.y = cvtpk(v[r][j].z, v[r][j].w); o8[64 * j] = w; } }
            }
        }
    }
}
    SEAM(0);
    { int t0_ = MY_TID(); asm volatile("" : "+v"(t0_));
      if (t0_ == 0) { unsigned pre = 0u, c[16]; xb_ld16(ctl + CW_BAR, c);
#pragma unroll
          for (unsigned j = 0; j < 16; ++j) pre += (j < bar.x) ? c[j] : 0u;
          MISC[17] = (lo == 0 && hi > 1) ? (pre + MISC[16]) : (unsigned)F.bid; }
      __syncthreads(); }
    const int vcu = (int)MISC[17];

    if (IN(1)) {
        PHASE_IDS();
#pragma unroll 1
        for (int rep_ = 0; rep_ <= ((REPMASK >> 1) & 1); ++rep_) {
      if constexpr (FASTMASK & 1) {
        const int wid = PW, lane = PL;
        constexpr int NCT = QKVW / 256, NU = (NTOK / 256) * NCT;
        for (int u = vcu; u < NU; u += F.G) {
            const int pm = u / NCT, pn = u % NCT;
            GldsKc al, bl;
            al.init(Hb, [&](int R) { return (pm * 256 + R) * DM; }, PT);
            bl.init(WqkvT, [&](int R) { return (pn * 256 + R) * DM; }, PT);
            f32x4 acc[8][4];
            fgemm2<0, 0>(F.lds, al, bl, DM / 64, acc, PT);
                    EPI_IDS();
            { float rs8[8];
#pragma unroll
              for (int m = 0; m < 8; ++m) rs8[m] = RS0[pm * 256 + wr * 128 + m * 16 + fr];
#pragma unroll
              for (int m = 0; m < 8; ++m)
#pragma unroll
                  for (int n = 0; n < 4; ++n) acc[m][n] = acc[m][n] * rs8[m]; }
            if (pn < 12) {
                LAS float* SS = (LAS float*)(F.lds + MISC_OFF + 2048);
#pragma unroll
                for (int m = 0; m < 8; ++m) { float ss = 0.f;
#pragma unroll
                    for (int n = 0; n < 4; ++n) ss += (acc[m][n][0] * acc[m][n][0] + acc[m][n][1] * acc[m][n][1]) + (acc[m][n][2] * acc[m][n][2] + acc[m][n][3] * acc[m][n][3]);
                    ss += xshfl<16>(ss); ss = half_sum(ss);
                    if (fq == 0) SS[(wr * 128 + m * 16 + fr) * 4 + wc] = ss; }
                __syncthreads();
                const float* gn = (pn < 6 ? args.in[3] : args.in[4]) + (wc & 1) * 64 + 4 * fq;
                f32x4 gv[4];
#pragma unroll
                for (int n = 0; n < 4; ++n) gv[n] = *(const f32x4*)(gn + n * 16);
#pragma unroll
                for (int mh = 0; mh < 2; ++mh) {
                    f32x4 rp0[4], rp1[4];
#pragma unroll
                    for (int m4 = 0; m4 < 4; ++m4) { const int pos = (pm * 256 + wr * 128 + (mh * 4 + m4) * 16 + fr) & (SEQ - 1);
                        rp0[m4] = *(const f32x4*)(ROPE + (pos * 16 + 4 * fq) * 2); rp1[m4] = *(const f32x4*)(ROPE + (pos * 16 + 4 * fq) * 2 + 4); }
#pragma unroll
                    for (int m4 = 0; m4 < 4; ++m4) { const int m = mh * 4 + m4; const int row = wr * 128 + m * 16 + fr; const float tot = SS[row * 4 + wc] + SS[row * 4 + (wc ^ 1)];
                        const float rstd = 1.0f / sqrtf(tot * (1.f / 128.f) + EPS);
#pragma unroll
                        for (int n = 0; n < 4; ++n) acc[m][n] = acc[m][n] * rstd * gv[n];
                        { const bool ev = (wc & 1) == 0; const f32x4 r0 = rp0[m4], r1 = rp1[m4];
                            const float cs[4] = {ev ? r0.x : 1.f, ev ? r0.z : 1.f, ev ? r1.x : 1.f, ev ? r1.z : 1.f}, sn[4] = {ev ? r0.y : 0.f, ev ? r0.w : 0.f, ev ? r1.y : 0.f, ev ? r1.w : 0.f};
#pragma unroll
                            for (int j = 0; j < 4; ++j) { const float t1 = acc[m][0][j], t2 = acc[m][1][j]; acc[m][0][j] = t1 * cs[j] - t2 * sn[j]; acc[m][1][j] = t2 * cs[j] + t1 * sn[j]; } } }
                }
            }
#pragma unroll
            for (int m = 0; m < 8; ++m) { bf16* o = QKV + (size_t)(pm * 256 + wr * 128 + m * 16 + fr) * QKVW + pn * 256 + wc * 64 + 4 * fq;
#pragma unroll
                for (int n = 0; n < 4; ++n) { u32x2 w; w.x = cvtpk(acc[m][n][0], acc[m][n][1]); w.y = cvtpk(acc[m][n][2], acc[m][n][3]); *(u32x2*)(o + n * 16) = w; } }
        }
        for (int u = (vcu + 128) % F.G; u < 64; u += F.G) {
            const int g = u >> 3, pn = u & 7;
            GldsKc al, bl;
            al.init(TT, [&](int R) { return R * 256; }, PT);
            bl.init(WinB, [&](int R) { return (pn * 256 + R) * DM + g * 256; }, PT);
            f32x4 acc[8][4];
            fgemm2<0, 0>(F.lds, al, bl, 4, acc, PT);
                    EPI_IDS();
#pragma unroll
            for (int m = 0; m < 8; ++m) { bf16* o = WpT + (size_t)(g * 256 + wr * 128 + m * 16 + fr) * DM + pn * 256 + wc * 64 + 4 * fq;
#pragma unroll
                for (int n = 0; n < 4; ++n) { u32x2 w; w.x = cvtpk(acc[m][n][0], acc[m][n][1]); w.y = cvtpk(acc[m][n][2], acc[m][n][3]); *(u32x2*)(o + n * 16) = w; } }
        }
        { const int t0 = (NU % F.G) ? (NU % F.G) : 0;
          if (vcu >= t0) {
            const int gwt = (vcu - t0) * NWAVES + PW, ngwt = (F.G - t0) * NWAVES, gtt = (vcu - t0) * NTHR + PT, ngtt = (F.G - t0) * NTHR;
            LAS float* scr = (LAS float*)(F.lds + PW * 17408);
            const float* w_ao = args.in[5]; const float* w_fo = args.in[8];
            constexpr int I_AO = (AW / 64) * (DM / 64), I_W2 = (DM / 64) * (DM / 64);
            for (int it = gwt; it < I_AO + I_W2; it += ngwt) {
                int r = it;
                if (r < I_AO) { transpose_item([&](int k, int n) { return *(const f32x4*)(w_ao + (size_t)k * DM + n); }, DM, WoT, AW, scr, r, PL); continue; } r -= I_AO;
                transpose_item([&](int k, int n) {
                    const int g = k >> 8, jj = k & 255; const float* w = w_fo + (size_t)(g * 256) * DM + n;
                    const bool single = (jj & 127) == 0; const int ja = jj <= 128 ? jj : 384 - jj, jb = single ? ja : (jj < 128 ? 256 - jj : jj - 128);
                    const float sg = single ? 0.f : (jj < 128 ? 1.f : -1.f);
                    const f32x4 a = *(const f32x4*)(w + (size_t)ja * DM), b = *(const f32x4*)(w + (size_t)jb * DM);
                    return a + b * sg; }, DM, W2T, DM, scr, r, PL);
            }
            for (int i = gtt; i < SEQ * SEQ; i += ngtt) { const int k1 = i >> 11, s = i & 2047; const float a = (float)((k1 * s) & 2047) * (1.0f / 1024.0f);
                HART[i] = (bf16)f2bf((cospif(a) + sinpif(a)) * 0.02209708691207961f); }
            { bf16* RT = (bf16*)(ws + WS_RTAB);
              for (int i = gtt; i < 2 * 80 * DM; i += ngtt) { const int layer = i / (80 * DM), r = i % (80 * DM), n = r / DM, k = r % DM; float w = 0.f;
                  if (n < 8) w = args.in[10][(size_t)layer * DM * 8 + k * 8 + n]; else if (n < 72) w = args.in[12][(size_t)layer * DM * 64 + k * 64 + (n - 8)];
                  const unsigned hi = f2bf(w); const float lo = w - bf2f((bf16)hi);
                  const int d = (((k >> 5) * 5 + (n >> 4)) * 64 + ((k >> 3) & 3) * 16 + (n & 15)) * 8 + (k & 7);
                  RT[(size_t)(layer * 2 + 0) * 80 * DM + d] = (bf16)hi; RT[(size_t)(layer * 2 + 1) * 80 * DM + d] = (bf16)f2bf(lo); } }
          } }
      } else {
        LAS float* sm = (LAS float*)F.lds;
        const int ty = PT >> 4, tx = PT & 15;
        const int NU = (NTOK / 128) * (QKVW / 128);
        for (int u = F.bid; u < NU; u += F.G) {
            const int pm = u / (QKVW / 128), pn = u % (QKVW / 128);
            float acc[4][8];
            const bf16* Ap = Hb + (size_t)pm * 128 * DM; const bf16* Bp = WqkvT + (size_t)pn * 128 * DM;
            ngemm_tile<true, true>(sm, DM, [&](int i, int k) { return bf2f(Ap[(size_t)i * DM + k]); }, [&](int k, int j) { return bf2f(Bp[(size_t)j * DM + k]); }, acc);
#pragma unroll
            for (int r = 0; r < 4; ++r) { bf16* o = QKV + (size_t)(pm * 128 + ty * 4 + r) * QKVW + pn * 128 + tx * 8;
                u32x4 w; w.x = pk2(acc[r][0], acc[r][1]); w.y = pk2(acc[r][2], acc[r][3]); w.z = pk2(acc[r][4], acc[r][5]); w.w = pk2(acc[r][6], acc[r][7]); *(u32x4*)o = w; }
        }
        const int NF = 16 * 16;
        for (int u = F.bid; u < NF; u += F.G) {
            const int pm = u / 16, pn = u % 16;
            const int g = pm >> 1, j0 = (pm & 1) * 128;
            float acc[4][8];
            ngemm_tile<true, true>(sm, 256, [&](int i, int k) { return bf2f(TT[(j0 + i) * 256 + k]); }, [&](int k, int j) { return bf2f(WinB[(size_t)(pn * 128 + j) * DM + g * 256 + k]); }, acc);
#pragma unroll
            for (int r = 0; r < 4; ++r) { bf16* o = WpT + (size_t)(pm * 128 + ty * 4 + r) * DM + pn * 128 + tx * 8;
                u32x4 w; w.x = pk2(acc[r][0], acc[r][1]); w.y = pk2(acc[r][2], acc[r][3]); w.z = pk2(acc[r][4], acc[r][5]); w.w = pk2(acc[r][6], acc[r][7]); *(u32x4*)o = w; }
        }
          }
    }
}
    SEAM(1);

    if (IN(2) && !(FASTMASK & 1)) {
        PHASE_IDS();
        const float* qg = args.in[3]; const float* kg = args.in[4];
        for (int it = gw; it < NTOK * 24; it += NGW) {
            const int tok = it / 24, hh = it % 24; const int isk = hh >= 12; const int pos = tok & (SEQ - 1);
            bf16* p = QKV + (size_t)tok * QKVW + hh * 128 + 2 * PL;
            const unsigned raw = *(const unsigned*)p;
            float a = bf2f((bf16)(raw & 0xffff)), b = bf2f((bf16)(raw >> 16));
            const float ss = wave_sum(a * a + b * b);
            const float rstd = 1.0f / sqrtf(ss * (1.f / 128.f) + EPS);
            const float* gg = (isk ? kg : qg) + 2 * PL;
            a = a * rstd * gg[0]; b = b * rstd * gg[1];
            const float pa = __shfl_xor(a, 8), pb = __shfl_xor(b, 8);
            if (PL < 16) {
                const int d0 = (2 * PL) & 15;
                const float c0 = ROPE[(pos * 16 + d0) * 2], s0 = ROPE[(pos * 16 + d0) * 2 + 1], c1 = ROPE[(pos * 16 + d0 + 1) * 2], s1 = ROPE[(pos * 16 + d0 + 1) * 2 + 1];
                if (PL < 8) { a = a * c0 - pa * s0; b = b * c1 - pb * s1; }
                else { a = a * c0 + pa * s0; b = b * c1 + pb * s1; }
            }
            *(unsigned*)p = pk2(a, b);
        }
    }
    if (!(FASTMASK & 1)) SEAM(2);

    if (IN(3)) {
        PHASE_IDS();
#pragma unroll 1
        for (int rep_ = 0; rep_ <= ((REPMASK >> 3) & 1); ++rep_) {
      if constexpr (FASTMASK & 256) {
        LAS unsigned char* Kim = F.lds; LAS unsigned char* Vim = F.lds + 65536;
        const int fr = PL & 15, fq = PL >> 4;
        constexpr int NITEM = BATCH * NHEAD * 16;
#pragma unroll 1
        for (int it = vcu; it < NITEM; it += F.G) {
            const int b = it / (NHEAD * 16), h = (it >> 4) % NHEAD, sub = it & 15; const int grp = h >> 2;
            const int dsh = 2 * grp, dil = 1 << dsh, L = SEQ >> dsh, nqbs = 4 - dsh;
            const int r = sub >> nqbs, qb = sub & ((1 << nqbs) - 1);
            const int kbase = 128 * qb - 64;
            { const int c = PT & 15, row0 = PT >> 4;
              u32x4 kv[8], vv[8];
#pragma unroll
              for (int i = 0; i < 8; ++i) { const int row = row0 + 32 * i, jk = kbase + row; const bool ok = (jk >= 0) && (jk < L);
                  const bf16* src = QKV + (size_t)((b << 11) + (ok ? jk : 0) * dil + r) * QKVW + AW + h * 128 + 8 * c;
                  kv[i] = ok ? *(const u32x4*)src : (u32x4){0u, 0u, 0u, 0u}; vv[i] = ok ? *(const u32x4*)(src + AW) : (u32x4){0u, 0u, 0u, 0u}; }
#pragma unroll
              for (int i = 0; i < 8; ++i) { const int row = row0 + 32 * i; const int fx = (row & 3) | (((row >> 3) & 3) << 2);
                  *(LAS u32x4*)(Kim + row * 256 + ((c ^ fx) << 4)) = kv[i];
                  *(LAS u32x4*)(Vim + row * 288 + ((16 * c) ^ (((row >> 3) & 1) << 7))) = vv[i]; } }
            const int jq0 = 128 * qb + 16 * PW;
            bf16x8 qf[4];
            { const bf16* qp = QKV + (size_t)((b << 11) + (jq0 + fr) * dil + r) * QKVW + h * 128 + 8 * fq;
#pragma unroll
              for (int k = 0; k < 4; ++k) qf[k] = *(const bf16x8*)(qp + 32 * k); }
            __syncthreads();
            const int a0 = PW >> 1;
            f32x4 sreg[5][2];
#pragma unroll
            for (int st = 0; st < 5; ++st)
#pragma unroll
                for (int t2 = 0; t2 < 2; ++t2) { f32x4 acc = {0.f, 0.f, 0.f, 0.f};
                    const int krow = 32 * (a0 + st) + 8 * (fr >> 2) + 4 * t2 + (fr & 3);
#pragma unroll
                    for (int k = 0; k < 4; ++k) { const bf16x8 kf = *(const LAS bf16x8*)(Kim + krow * 256 + (((4 * k + fq) ^ fr) << 4));
                        acc = __builtin_amdgcn_mfma_f32_16x16x32_bf16(kf, qf[k], acc, 0, 0, 0); }
                    sreg[st][t2] = acc; }
            const int jq = jq0 + fr; float mx = -3.0e38f;
#pragma unroll
            for (int st = 0; st < 5; ++st)
#pragma unroll
                for (int t2 = 0; t2 < 2; ++t2)
#pragma unroll
                    for (int j = 0; j < 4; ++j) { const int jk = kbase + 32 * (a0 + st) + 8 * fq + 4 * t2 + j; const int dlt = jk - jq;
                        const bool ok = (dlt <= 64) && (dlt >= -64) && (jk >= 0) && (jk < L);
                        const float sv = ok ? sreg[st][t2][j] * 0.08838834764831845f : -1.0e30f; sreg[st][t2][j] = sv; mx = fmaxf(mx, sv); }
            mx = fmaxf(mx, xshfl<16>(mx)); mx = half_max(mx);
            float sum = 0.f; bf16x8 pf[5];
#pragma unroll
            for (int st = 0; st < 5; ++st) { float pv[8];
#pragma unroll
                for (int t2 = 0; t2 < 2; ++t2)
#pragma unroll
                    for (int j = 0; j < 4; ++j) { const float sv = sreg[st][t2][j]; const float p = (sv > -1.0e29f) ? __expf(sv - mx) : 0.f; pv[4 * t2 + j] = p; sum += p; }
                u32x4 w; w.x = cvtpk(pv[0], pv[1]); w.y = cvtpk(pv[2], pv[3]); w.z = cvtpk(pv[4], pv[5]); w.w = cvtpk(pv[6], pv[7]); pf[st] = __builtin_bit_cast(bf16x8, w); }
            sum += xshfl<16>(sum); sum = half_sum(sum);
            f32x4 oacc[8];
#pragma unroll
            for (int nt = 0; nt < 8; ++nt) oacc[nt] = (f32x4){0.f, 0.f, 0.f, 0.f};
            { const int g = fq, q = (PL & 15) >> 2, p = PL & 3;
              const int vb0 = (8 * g + q) * 288 + ((8 * p) ^ ((g & 1) << 7)), vb1 = (8 * g + q) * 288 + ((128 + 8 * p) ^ ((g & 1) << 7));
#pragma unroll
              for (int st = 0; st < 5; ++st)
#pragma unroll
                  for (int nt = 0; nt < 8; ++nt) { s16x4 hh[2];
#pragma unroll
                      for (int tt = 0; tt < 2; ++tt) hh[tt] = __builtin_amdgcn_ds_read_tr16_b64_v4i16((LAS s16x4*)(Vim + ((nt & 4) ? vb1 : vb0) + (32 * (a0 + st) + 4 * tt) * 288 + 32 * (nt & 3)));
                      const bf16x8 vf = __builtin_shufflevector(hh[0], hh[1], 0, 1, 2, 3, 4, 5, 6, 7);
                      oacc[nt] = __builtin_amdgcn_mfma_f32_16x16x32_bf16(vf, pf[st], oacc[nt], 0, 0, 0); } }
            const float inv = 1.0f / sum; const int tokq = (b << 11) + jq * dil + r;
            bf16* op = Ob + (size_t)tokq * AW + h * 128 + 4 * fq;
#pragma unroll
            for (int nt = 0; nt < 8; ++nt) { u32x2 w; w.x = cvtpk(oacc[nt][0] * inv, oacc[nt][1] * inv); w.y = cvtpk(oacc[nt][2] * inv, oacc[nt][3] * inv); *(u32x2*)(op + 16 * nt) = w; }
            if (fq == 0) LSE[tokq * NHEAD + h] = mx + __logf(sum);
            __syncthreads();
        }
      } else {
        LAS float* qs = (LAS float*)(F.lds + PW * 2048);
        LAS float* ps = qs + 128;
        for (int it = gw; it < NTOK * NHEAD; it += NGW) {
            const int tok = it / NHEAD, h = it % NHEAD; const int b = tok >> 11, s = tok & 2047;
            const int grp = h >> 2; const int dil = grp == 0 ? 1 : (grp == 1 ? 4 : 16); const int L = SEQ / dil;
            const int j = s / dil, r = s % dil;
            const int jlo = max(0, j - 64), jhi = min(L - 1, j + 64); const int nk = jhi - jlo + 1;
            { const unsigned raw = *(const unsigned*)(QKV + (size_t)tok * QKVW + h * 128 + 2 * PL); qs[2 * PL] = bf2f((bf16)(raw & 0xffff)); qs[2 * PL + 1] = bf2f((bf16)(raw >> 16)); }
            asm volatile("s_waitcnt lgkmcnt(0)" ::: "memory");
            float sc[3]; float mx = -3.0e38f;
#pragma unroll
            for (int q = 0; q < 3; ++q) { const int ki = PL + 64 * q; sc[q] = -3.0e38f;
                if (ki < nk) { const int tk = (b << 11) + (jlo + ki) * dil + r; const bf16* kp = QKV + (size_t)tk * QKVW + AW + h * 128; float d = 0.f;
                    for (int c = 0; c < 16; ++c) { const u32x4 kv = *(const u32x4*)(kp + 8 * c); const unsigned w[4] = {kv.x, kv.y, kv.z, kv.w};
#pragma unroll
                        for (int e = 0; e < 4; ++e) { d += qs[8 * c + 2 * e] * bf2f((bf16)(w[e] & 0xffff)) + qs[8 * c + 2 * e + 1] * bf2f((bf16)(w[e] >> 16)); } }
                    sc[q] = d * 0.08838834764831845f; mx = fmaxf(mx, sc[q]); } }
            mx = wave_max(mx);
            float sum = 0.f;
#pragma unroll
            for (int q = 0; q < 3; ++q) { const int ki = PL + 64 * q; const float p = (ki < nk) ? __expf(sc[q] - mx) : 0.f; sum += p; ps[ki] = p; }
            sum = wave_sum(sum);
            asm volatile("s_waitcnt lgkmcnt(0)" ::: "memory");
            float o0 = 0.f, o1 = 0.f;
            for (int ki = 0; ki < nk; ++ki) { const int tk = (b << 11) + (jlo + ki) * dil + r; const unsigned raw = *(const unsigned*)(QKV + (size_t)tk * QKVW + 2 * AW + h * 128 + 2 * PL);
                const float p = ps[ki]; o0 += p * bf2f((bf16)(raw & 0xffff)); o1 += p * bf2f((bf16)(raw >> 16)); }
            const float inv = 1.0f / sum;
            *(unsigned*)(Ob + (size_t)tok * AW + h * 128 + 2 * PL) = pk2(o0 * inv, o1 * inv);
            if (PL == 0) LSE[tok * NHEAD + h] = mx + __logf(sum);
            asm volatile("s_waitcnt lgkmcnt(0)" ::: "memory");
        }
          }
    }
}
    SEAM(3);

    if (IN(4) && !(FASTMASK & 2)) {
        PHASE_IDS();
#pragma unroll 1
        for (int rep_ = 0; rep_ <= ((REPMASK >> 4) & 1); ++rep_) {
        for (int i0 = gt; i0 < NTOK * (AW / 8); i0 += 4 * NGT) {
            u32x4 vv[4]; float al[4];
#pragma unroll
            for (int q = 0; q < 4; ++q) { const int i = i0 + q * NGT; const int tok = i / (AW / 8), c = i % (AW / 8); const int h = c >> 4, hg = h & 3;
                const float l0 = LSE[tok * NHEAD + hg], l1 = LSE[tok * NHEAD + 4 + hg], l2 = LSE[tok * NHEAD + 8 + hg];
                vv[q] = *(const u32x4*)(Ob + (size_t)tok * AW + c * 8);
                const float m = fmaxf(l0, fmaxf(l1, l2)); const float e0 = __expf(l0 - m), e1 = __expf(l1 - m), e2 = __expf(l2 - m);
                const float mine = (h >> 2) == 0 ? e0 : ((h >> 2) == 1 ? e1 : e2); al[q] = mine / (e0 + e1 + e2); }
#pragma unroll
            for (int q = 0; q < 4; ++q) { const int i = i0 + q * NGT; const int tok = i / (AW / 8), c = i % (AW / 8); const u32x4 v = vv[q]; const float a = al[q]; u32x4 o;
                o.x = cvtpk(bf2f((bf16)(v.x & 0xffff)) * a, bf2f((bf16)(v.x >> 16)) * a); o.y = cvtpk(bf2f((bf16)(v.y & 0xffff)) * a, bf2f((bf16)(v.y >> 16)) * a);
                o.z = cvtpk(bf2f((bf16)(v.z & 0xffff)) * a, bf2f((bf16)(v.z >> 16)) * a); o.w = cvtpk(bf2f((bf16)(v.w & 0xffff)) * a, bf2f((bf16)(v.w >> 16)) * a);
                *(u32x4*)(MIXb + (size_t)tok * AW + c * 8) = o; }
        }
    }
}
    if (!(FASTMASK & 2)) SEAM(4);

    if (IN(5)) {
        PHASE_IDS();
#pragma unroll 1
        for (int rep_ = 0; rep_ <= ((REPMASK >> 5) & 1); ++rep_) {
      if constexpr (FASTMASK & 2) {
        const int wid = PW, lane = PL;
        constexpr int NCT = DM / 256, NU = (NTOK / 256) * NCT;
        for (int u = vcu; u < NU; u += F.G) {
            const int pm = u / NCT, pn = u % NCT;
            MixA al; GldsKc bl;
            al.init(Ob, LSE, pm * 256, PT);
            bl.init(WoT, [&](int R) { return (pn * 256 + R) * AW; }, PT);
            f32x4 acc[8][4];
            fgemm2<0, 0>(F.lds, al, bl, AW / 64, acc, PT);
                    EPI_IDS();
            f32x4 gm[4];
#pragma unroll
            for (int n = 0; n < 4; ++n) gm[n] = *(const f32x4*)(args.in[9] + pn * 256 + wc * 64 + n * 16 + 4 * fq);
#pragma unroll
            for (int mh = 0; mh < 2; ++mh) {
                u32x2 xr[4][4];
#pragma unroll
                for (int m = 0; m < 4; ++m) { const size_t off = (size_t)(pm * 256 + wr * 128 + (mh * 4 + m) * 16 + fr) * DM + pn * 256 + wc * 64 + 4 * fq;
#pragma unroll
                    for (int n = 0; n < 4; ++n) xr[m][n] = *(const u32x2*)(Hb + off + n * 16); }
#pragma unroll
                for (int m = 0; m < 4; ++m) { const int row = pm * 256 + wr * 128 + (mh * 4 + m) * 16 + fr; const size_t off = (size_t)row * DM + pn * 256 + wc * 64 + 4 * fq; float ss = 0.f;
#pragma unroll
                    for (int n = 0; n < 4; ++n) { const f32x4 v = unpk4(xr[m][n]) + acc[mh * 4 + m][n]; const f32x4 vg = v * gm[n]; u32x2 w; w.x = cvtpk(vg.x, vg.y); w.y = cvtpk(vg.z, vg.w); *(u32x2*)(XAh + off + n * 16) = w; ss += (v.x * v.x + v.y * v.y) + (v.z * v.z + v.w * v.w); }
                    ss += xshfl<16>(ss); ss = half_sum(ss); if (fq == 0) SSQ[row * 32 + pn * 4 + wc] = ss; } }
        }
      } else {
        LAS float* sm = (LAS float*)F.lds; const int ty = PT >> 4, tx = PT & 15;
        const int NU = (NTOK / 128) * (DM / 128);
        for (int u = F.bid; u < NU; u += F.G) {
            const int pm = u / (DM / 128), pn = u % (DM / 128);
            float acc[4][8];
            const bf16* Ap = MIXb + (size_t)pm * 128 * AW; const bf16* Bp = WoT + (size_t)pn * 128 * AW;
            ngemm_tile<true, true>(sm, AW, [&](int i, int k) { return bf2f(Ap[(size_t)i * AW + k]); }, [&](int k, int j) { return bf2f(Bp[(size_t)j * AW + k]); }, acc);
#pragma unroll
            for (int r = 0; r < 4; ++r) { const size_t off = (size_t)(pm * 128 + ty * 4 + r) * DM + pn * 128 + tx * 8;
                const f32x4 x0 = *(const f32x4*)(args.in[0] + off), x1 = *(const f32x4*)(args.in[0] + off + 4);
                *(f32x4*)(XA + off) = (f32x4){x0.x + acc[r][0], x0.y + acc[r][1], x0.z + acc[r][2], x0.w + acc[r][3]};
                *(f32x4*)(XA + off + 4) = (f32x4){x1.x + acc[r][4], x1.y + acc[r][5], x1.z + acc[r][6], x1.w + acc[r][7]}; }
        }
          }
    }
}
    SEAM(5);

#pragma unroll 1
    for (int layer = 0; layer < 2; ++layer) {
        const int PB = layer == 0 ? 6 : 13;
        const float* xin = XA;
        const float* mg = args.in[9] + layer * DM;
        const float* wrg = args.in[10] + (size_t)layer * DM * 8; const float* brg = args.in[11] + layer * 8;
        const float* wre = args.in[12] + (size_t)layer * DM * 64; const float* bre = args.in[13] + layer * 64;
        const float* wgate = args.in[14] + (size_t)layer * NE * DM * DE; const float* wup = args.in[15] + (size_t)layer * NE * DM * DE; const float* wdown = args.in[16] + (size_t)layer * NE * DE * DM;
        unsigned* cnt = CNT + layer * 64; unsigned* done = ctl + CW_DONE + layer * 4096; unsigned* qhead = ctl + CW_Q + layer * 64;

        if (IN(PB)) {
            PHASE_IDS();
          if constexpr (FASTMASK & 128) {
            const bf16* RThi = (const bf16*)(ws + WS_RTAB) + (size_t)(layer * 2) * 80 * DM; const bf16* RTlo = RThi + (size_t)80 * DM;
            const int th = PW >> 2, kq = PW & 3;
            LAS float* Ls = (LAS float*)(F.lds + (th * 4 + kq) * 10240);
            const int fr = PL & 15, fq = PL >> 4;
            const int NTASK = NTOK / 64;
#pragma unroll 1
            for (int rep_ = 0; rep_ <= ((REPMASK >> 6) & 1); ++rep_)
#pragma unroll 1
            for (int tb = F.bid; tb < NTASK; tb += F.G) {
                const int tok0 = tb * 64 + th * 32;
                float myr[2];
#pragma unroll
                for (int rg = 0; rg < 2; ++rg) { const f32x4* sp = (const f32x4*)(SSQ + (size_t)(tok0 + 16 * rg + fr) * 32); float sq = 0.f;
#pragma unroll
                  for (int j = 0; j < 8; ++j) { const f32x4 v = sp[j]; sq += (v.x + v.y) + (v.z + v.w); }
                  myr[rg] = 1.0f / sqrtf(sq * (1.f / DM) + EPS); }
                f32x4 acc[2][5];
#pragma unroll
                for (int rg = 0; rg < 2; ++rg)
#pragma unroll
                    for (int n = 0; n < 5; ++n) acc[rg][n] = (f32x4){0.f, 0.f, 0.f, 0.f};
                const bf16* xrow = XAh + (size_t)(tok0 + fr) * DM + 8 * fq + kq * (DM / 4); const float* grow = mg + 8 * fq + kq * (DM / 4); bf16* hrow = Hb + (size_t)(tok0 + fr) * DM + 8 * fq + kq * (DM / 4);
                const bf16* bh = RThi + ((size_t)(kq * 16) * 5 * 64 + PL) * 8; const bf16* bl = RTlo + ((size_t)(kq * 16) * 5 * 64 + PL) * 8;
                u32x4 cx[2], nx[2]; f32x4 cg[2], ng[2]; bf16x8 cwh[5], cwl[5], nwh[5], nwl[5];
#define RT_LOAD(ks, x_, g_, wh_, wl_) do { x_[0] = *(const u32x4*)(xrow + 32 * (ks)); x_[1] = *(const u32x4*)(xrow + 16 * DM + 32 * (ks)); \
                        g_[0] = *(const f32x4*)(grow + 32 * (ks)); g_[1] = *(const f32x4*)(grow + 32 * (ks) + 4); \
                        _Pragma("unroll") for (int n = 0; n < 5; ++n) { wh_[n] = *(const bf16x8*)(bh + (size_t)((ks) * 5 + n) * 512); wl_[n] = *(const bf16x8*)(bl + (size_t)((ks) * 5 + n) * 512); } } while (0)
#define RT_STEP(ks, x_, g_, wh_, wl_) do { _Pragma("unroll") for (int rg = 0; rg < 2; ++rg) { const u32x4 xw_ = x_[rg]; const f32x4 xa = unpk4((u32x2){xw_.x, xw_.y}), xb = unpk4((u32x2){xw_.z, xw_.w}); const float mr = myr[rg]; \
                        float hv[8] = {xa.x * mr, xa.y * mr, xa.z * mr, xa.w * mr, xb.x * mr, xb.y * mr, xb.z * mr, xb.w * mr};        \
                        u32x4 hi, lo; unsigned* hp = (unsigned*)&hi; unsigned* lp = (unsigned*)&lo; \
                        _Pragma("unroll") for (int j = 0; j < 4; ++j) { const unsigned h2 = cvtpk(hv[2 * j], hv[2 * j + 1]); hp[j] = h2; \
                            lp[j] = cvtpk(hv[2 * j] - __uint_as_float(h2 << 16), hv[2 * j + 1] - __uint_as_float(h2 & 0xffff0000u)); } \
                        const bf16x8 ah = __builtin_bit_cast(bf16x8, hi), al_ = __builtin_bit_cast(bf16x8, lo); \
                        _Pragma("unroll") for (int n = 0; n < 5; ++n) { \
                            acc[rg][n] = __builtin_amdgcn_mfma_f32_16x16x32_bf16(ah, wh_[n], acc[rg][n], 0, 0, 0); \
                            acc[rg][n] = __builtin_amdgcn_mfma_f32_16x16x32_bf16(ah, wl_[n], acc[rg][n], 0, 0, 0); \
                            acc[rg][n] = __builtin_amdgcn_mfma_f32_16x16x32_bf16(al_, wh_[n], acc[rg][n], 0, 0, 0); } } } while (0)
                RT_LOAD(0, cx, cg, cwh, cwl);
#pragma unroll 1
                for (int ks = 0; ks < 16; ks += 2) {
                    RT_LOAD(ks + 1, nx, ng, nwh, nwl);
                    __builtin_amdgcn_sched_barrier(0);
                    RT_STEP(ks, cx, cg, cwh, cwl);
                    __builtin_amdgcn_sched_barrier(0);
                    { const int k2 = (ks + 2 < 16) ? ks + 2 : ks; RT_LOAD(k2, cx, cg, cwh, cwl); }
                    __builtin_amdgcn_sched_barrier(0);
                    RT_STEP(ks + 1, nx, ng, nwh, nwl);
                    __builtin_amdgcn_sched_barrier(0);
                }
#undef RT_STEP
#undef RT_LOAD
#pragma unroll
                for (int rg = 0; rg < 2; ++rg)
#pragma unroll
                    for (int n = 0; n < 5; ++n)
#pragma unroll
                        for (int j = 0; j < 4; ++j) Ls[(16 * rg + 4 * fq + j) * 80 + n * 16 + fr] = acc[rg][n][j];
                __syncthreads();
                if (kq == 0 && PL < 32 && rep_ == ((REPMASK >> 6) & 1)) {
                    const int tok = tok0 + PL; const LAS float* L = Ls + PL * 80;
#define LG(i_) (L[i_] + L[2560 + (i_)] + L[5120 + (i_)] + L[7680 + (i_)])
                    float cm = LG(0) + brg[0]; int gsel = 0; float cv[8]; cv[0] = cm;
#pragma unroll
                    for (int j = 1; j < 8; ++j) { cv[j] = LG(j) + brg[j]; if (cv[j] > cm) { cm = cv[j]; gsel = j; } }
                    float cs = 0.f;
#pragma unroll
                    for (int j = 0; j < 8; ++j) cs += __expf(cv[j] - cm);
                    const float ggate = 1.0f / cs;
                    float f1 = -3.0e38f, f2 = -3.0e38f; int i1 = 0, i2 = 0;
                    const f32x4 be0 = *(const f32x4*)(bre + gsel * 8), be1 = *(const f32x4*)(bre + gsel * 8 + 4);
                    const float bb[8] = {be0.x, be0.y, be0.z, be0.w, be1.x, be1.y, be1.z, be1.w};
#pragma unroll
                    for (int j = 0; j < 8; ++j) { const float fv = LG(8 + gsel * 8 + j) + bb[j];
                        const bool g1 = fv > f1, g2 = fv > f2;
                        f2 = g1 ? f1 : (g2 ? fv : f2); i2 = g1 ? i1 : (g2 ? j : i2); f1 = g1 ? fv : f1; i1 = g1 ? j : i1; }
#undef LG
                    const float e2 = __expf(f2 - f1); const float w1 = ggate / (1.0f + e2), w2 = ggate * e2 / (1.0f + e2);
                    const int ex1 = gsel * 8 + i1, ex2 = gsel * 8 + i2;
                    const int p1 = (int)atomicAdd(cnt + ex1, 1u), p2 = (int)atomicAdd(cnt + ex2, 1u);
                    TOKL[ex1 * NTOK + p1] = tok; TOKL[ex2 * NTOK + p2] = tok;
                    { const float rs_ = (PL < 16) ? myr[0] : myr[1]; RSL[ex1 * NTOK + p1] = rs_; RSL[ex2 * NTOK + p2] = rs_; }
                    SLOT[tok * 4 + 0] = ex1; SLOT[tok * 4 + 1] = p1; SLOT[tok * 4 + 2] = ex2; SLOT[tok * 4 + 3] = p2;
                    SLOTW[tok * 2] = w1; SLOTW[tok * 2 + 1] = w2;
                }
                __syncthreads();
            }
          } else {
            LAS float* hs = (LAS float*)(F.lds + PW * 8192);
            for (int tok = gw; tok < NTOK; tok += NGW) {
                const f32x4* xr = (const f32x4*)(xin + (size_t)tok * DM) + PL; const f32x4* gr = (const f32x4*)mg + PL;
                f32x4 v[8]; float s = 0.f;
#pragma unroll
                for (int j = 0; j < 8; ++j) { v[j] = xr[64 * j]; s += (v[j].x * v[j].x + v[j].y * v[j].y) + (v[j].z * v[j].z + v[j].w * v[j].w); }
                const float rstd = 1.0f / sqrtf(wave_sum(s) * (1.f / DM) + EPS);
                u32x2* o8 = (u32x2*)(Hb + (size_t)tok * DM) + PL;
#pragma unroll
                for (int j = 0; j < 8; ++j) { const f32x4 gg = gr[64 * j]; f32x4 hv = {v[j].x * rstd * gg.x, v[j].y * rstd * gg.y, v[j].z * rstd * gg.z, v[j].w * rstd * gg.w};
                    u32x2 w; w.x = pk2(hv.x, hv.y); w.y = pk2(hv.z, hv.w); o8[64 * j] = w; ((LAS f32x4*)hs)[PL + 64 * j] = hv; }
                asm volatile("s_waitcnt lgkmcnt(0)" ::: "memory");
                float fine = 0.f, coarse = 0.f;
                for (int d = 0; d < DM; ++d) { const float hv = hs[d]; fine += hv * wre[d * 64 + PL]; coarse += hv * wrg[d * 8 + (PL & 7)]; }
                fine += bre[PL]; coarse += brg[PL & 7];
                float cm = coarse; int ci = PL & 7;
#pragma unroll
                for (int o = 1; o < 8; o <<= 1) { const float om = __shfl_xor(cm, o); const int oi = __shfl_xor(ci, o); if (om > cm || (om == cm && oi < ci)) { cm = om; ci = oi; } }
                float ce = __expf(coarse - cm); float cs = ce;
#pragma unroll
                for (int o = 1; o < 8; o <<= 1) cs += __shfl_xor(cs, o);
                const float ggate = 1.0f / cs;
                const int gsel = __shfl(ci, 0); const float gg0 = __shfl(ggate, 0);
                float f1 = __shfl(fine, gsel * 8 + (PL & 7)); int i1 = PL & 7; const float fmine = f1;
#pragma unroll
                for (int o = 1; o < 8; o <<= 1) { const float om = __shfl_xor(f1, o); const int oi = __shfl_xor(i1, o); if (om > f1 || (om == f1 && oi < i1)) { f1 = om; i1 = oi; } }
                float f2 = ((PL & 7) == i1) ? -3.0e38f : fmine; int i2 = PL & 7;
#pragma unroll
                for (int o = 1; o < 8; o <<= 1) { const float om = __shfl_xor(f2, o); const int oi = __shfl_xor(i2, o); if (om > f2 || (om == f2 && oi < i2)) { f2 = om; i2 = oi; } }
                if (PL == 0) {
                    const float e2 = __expf(f2 - f1); const float w1 = gg0 / (1.0f + e2), w2 = gg0 * e2 / (1.0f + e2);
                    const int ex1 = gsel * 8 + i1, ex2 = gsel * 8 + i2;
                    const int p1 = (int)atomicAdd(cnt + ex1, 1u), p2 = (int)atomicAdd(cnt + ex2, 1u);
                    TOKL[ex1 * NTOK + p1] = tok; TOKL[ex2 * NTOK + p2] = tok;
                    SLOT[tok * 4 + 0] = ex1; SLOT[tok * 4 + 1] = p1; SLOT[tok * 4 + 2] = ex2; SLOT[tok * 4 + 3] = p2;
                    SLOTW[tok * 2] = w1; SLOTW[tok * 2 + 1] = w2;
                }
                asm volatile("s_waitcnt lgkmcnt(0)" ::: "memory");
            }
                  }
        }
        SEAM(PB);

        if (IN(PB + 1)) {
            PHASE_IDS();
#pragma unroll 1
        for (int rep_ = 0; rep_ <= ((REPMASK >> 7) & 1); ++rep_) {
            LAS int* tab = (LAS int*)(F.lds + MISC_OFF + 1024); moe_load_tab(tab, cnt, PT);
          if constexpr (FASTMASK & 4) {
            const int wid = PW, lane = PL;
            int u0 = 0;
#pragma unroll 1
            for (int e = 0; e < NE; ++e) {
                const int c = tab[e], nrt = (c + 255) >> 8, nu = nrt * 4, off = tab[NE + e];
#pragma unroll 1
                for (int u = u0 + ((vcu - (u0 % F.G) + F.G) % F.G); u < u0 + nu; u += F.G) {
                    const int ul = u - u0, ct = ul / nrt, rt = ul % nrt;
                    const int* tl = TOKL + e * NTOK + rt * 256; const int nrow = c - rt * 256;
                    const bool dummy_ = (PROBE_SAMEW && rep_ == 0 && ((REPMASK >> 7) & 1)); const int ew = dummy_ ? (PROBE_SAMEW == 4 ? ((e + 17 * rt + 5 * ct) & 63) : 0) : e, ctw = (dummy_ && PROBE_SAMEW >= 2 && PROBE_SAMEW != 4) ? 0 : ct;
                    const float* wg = wgate + (size_t)ew * DM * DE + ctw * 128; const float* wu = wup + (size_t)ew * DM * DE + ctw * 128;
                    GldsKc al; KnF32Loader bl;
                    const int tu_ = MY_TID(); const int lane = tu_ & 63, wid = PW;
                    int tk[4];
#pragma unroll
                    for (int i = 0; i < 4; ++i) tk[i] = tl[min((tu_ >> 3) + 64 * i, nrow - 1)];
                    asm volatile("" : "+v"(tk[0]), "+v"(tk[1]), "+v"(tk[2]), "+v"(tk[3]));
                    al.init_i(XAh, [&](int, int i) { return tk[i] * DM; }, tu_);
                    { const int n0 = 4 * lane, wcc = n0 >> 6, nn = (n0 >> 4) & 3; bl.init((nn < 2 ? wg : wu) + wcc * 32 + (nn & 1) * 16 + (n0 & 15) + (size_t)wid * DE, DE); }
                    if (PROBE_SAMEW == 3 && dummy_) bl.init(wgate + 4 * lane, 0);
                    f32x4 acc[8][4];
                    fgemm2<0, 1>(F.lds, al, bl, DM / 64, acc, PT);
                    EPI_IDS();
                    float rs8[8];
#pragma unroll
                    for (int m = 0; m < 8; ++m) rs8[m] = RSL[e * NTOK + rt * 256 + min(wr * 128 + m * 16 + fr, nrow - 1)];
#pragma unroll
                    for (int m = 0; m < 8; ++m) { if (wr * 128 + m * 16 + fr >= nrow) continue;
                        bf16* o = Ab + (size_t)(off + rt * 256 + wr * 128 + m * 16 + fr) * DE + ct * 128 + wc * 32 + 4 * fq;
#pragma unroll
                        for (int n = 0; n < 2; ++n) { float a[4];
#pragma unroll
                            for (int j = 0; j < 4; ++j) { const float gv = acc[m][n][j] * rs8[m]; a[j] = gv / (1.0f + __expf(-gv)) * (acc[m][n + 2][j] * rs8[m]); }
                            u32x2 w; w.x = cvtpk(a[0], a[1]); w.y = cvtpk(a[2], a[3]); *(u32x2*)(o + n * 16) = w; } }
                    asm volatile("s_waitcnt vmcnt(0)" ::: "memory"); __syncthreads();
                    if (MY_TID() == 0) { __builtin_amdgcn_fence(__ATOMIC_RELEASE, "agent"); (void)xb_add(done + e * 64 + rt, 1u); }
                }
                u0 += nu;
            }
          } else {
            LAS float* sm = (LAS float*)F.lds; const int ty = PT >> 4, tx = PT & 15;
            int u0 = 0;
            for (int e = 0; e < NE; ++e) {
                const int c = tab[e], nrt = (c + 127) >> 7, nu = nrt * 4, off = tab[NE + e];
                for (int u = u0 + ((F.bid - (u0 % F.G) + F.G) % F.G); u < u0 + nu; u += F.G) {
                    const int ul = u - u0, rt = ul >> 2, ct = ul & 3;
                    const int* tl = TOKL + e * NTOK + rt * 128; const int nrow = min(128, c - rt * 128);
                    const float* wg = wgate + (size_t)e * DM * DE + ct * 128; const float* wu = wup + (size_t)e * DM * DE + ct * 128;
                    float accg[4][8], accu[4][8];
                    auto af = [&](int i, int k) { const int t = (i < nrow) ? tl[i] : 0; return bf2f(Hb[(size_t)t * DM + k]); };
                    ngemm_tile<true, false>(sm, DM, af, [&](int k, int j) { return bf2f((bf16)f2bf(wg[(size_t)k * DE + j])); }, accg);
                    ngemm_tile<true, false>(sm, DM, af, [&](int k, int j) { return bf2f((bf16)f2bf(wu[(size_t)k * DE + j])); }, accu);
#pragma unroll
                    for (int r = 0; r < 4; ++r) { bf16* o = Ab + (size_t)(off + rt * 128 + ty * 4 + r) * DE + ct * 128 + tx * 8; float a[8];
#pragma unroll
                        for (int q = 0; q < 8; ++q) { const float g = accg[r][q]; a[q] = g / (1.0f + __expf(-g)) * accu[r][q]; }
                        u32x4 w; w.x = pk2(a[0], a[1]); w.y = pk2(a[2], a[3]); w.z = pk2(a[4], a[5]); w.w = pk2(a[6], a[7]); *(u32x4*)o = w; }
                }
                u0 += nu;
            }
                  }
        }
}

        if (IN(PB + 2)) {
            PHASE_IDS();
#pragma unroll 1
        for (int rep_ = 0; rep_ <= ((REPMASK >> 8) & 1); ++rep_) {
            LAS int* tab = (LAS int*)(F.lds + MISC_OFF + 1024); moe_load_tab(tab, cnt, PT);
          if constexpr (FASTMASK & 8) {
            { const int t0_ = MY_TID(); if (t0_ < NE) { int lo_ = 0; for (int e2 = (t0_ & 7); e2 < t0_; e2 += 8) lo_ += ((tab[e2] + 255) >> 8) * 8; tab[128 + t0_] = lo_; }
              if (t0_ == 0) MISC[22] = bar.x & 7u; }
            __syncthreads();
#define G2_FETCH() do { unsigned cur_ = MISC[22], res_ = 0xffffffffu; \
                for (int try_ = 0; try_ < 8; ++try_) { const int el_ = 56 + (int)cur_; const unsigned n_ = (unsigned)(tab[128 + el_] + ((tab[el_] + 255) >> 8) * 8); \
                    const unsigned k_ = xb_add(qhead + 8 * cur_, 1u); if (k_ < n_) { res_ = (cur_ << 24) | k_; break; } cur_ = (cur_ + 1u) & 7u; } \
                MISC[22] = cur_; MISC[20] = res_; } while (0)
            { const int t0_ = MY_TID(); if (t0_ == 0) G2_FETCH(); }
#pragma unroll 1
            for (;;) {
                __syncthreads();
                const unsigned qw = (unsigned)__builtin_amdgcn_readfirstlane((int)MISC[20]);
                if (qw == 0xffffffffu) break;
                const int qx = (int)(qw >> 24), q = (int)(qw & 0xffffffu);
                { const int t0_ = MY_TID(); if (t0_ < NE && (t0_ & 7) == qx) { const int lo_ = tab[128 + t0_], hi_ = lo_ + ((tab[t0_] + 255) >> 8) * 8; if (q >= lo_ && q < hi_) MISC[21] = (unsigned)t0_; } }
                __syncthreads();
                const int e = __builtin_amdgcn_readfirstlane((int)MISC[21]);
                const int c = tab[e], nrt = (c + 255) >> 8, off = tab[NE + e];
                const int ul = q - tab[128 + e], ct = ul / nrt, rt = ul % nrt;
                { const int t0_ = MY_TID();
                  if (t0_ == 0) { XB_SPIN(xb_ld(done + e * 64 + rt) < 4u, ctl + CW_BAR); __builtin_amdgcn_fence(__ATOMIC_ACQUIRE, "agent"); } }
                __syncthreads();
                { const int t0_ = MY_TID(); if (t0_ == 0) G2_FETCH(); }
                {
                    const bf16* Ap = Ab + (size_t)(off + rt * 256) * DE; const float* wd = wdown + (size_t)e * DE * DM + ct * 256;
                    GldsKc al; KnF32Loader bl;
                    const int tu_ = MY_TID(); const int lane = tu_ & 63, wid = PW;
                    al.init(Ap, [&](int R) { return R * DE; }, tu_);
                    bl.init(wd + 4 * lane + (size_t)wid * DM, DM);
                    f32x4 acc[8][4];
                    fgemm2<0, 1>(F.lds, al, bl, DE / 64, acc, PT);
                    EPI_IDS();
#pragma unroll
                    for (int m = 0; m < 8; ++m) { if (rt * 256 + wr * 128 + m * 16 + fr >= c) continue;
                        bf16* o = Yb + (size_t)(off + rt * 256 + wr * 128 + m * 16 + fr) * DM + ct * 256 + wc * 64 + 4 * fq;
#pragma unroll
                        for (int n = 0; n < 4; ++n) { u32x2 w; w.x = cvtpk(acc[m][n][0], acc[m][n][1]); w.y = cvtpk(acc[m][n][2], acc[m][n][3]); *(u32x2*)(o + n * 16) = w; } }
                }
            }
#undef G2_FETCH
          } else {
            LAS float* sm = (LAS float*)F.lds; const int ty = PT >> 4, tx = PT & 15;
            int u0 = 0;
            for (int e = 0; e < NE; ++e) {
                const int c = tab[e], nrt = (c + 127) >> 7, nu = nrt * 16, off = tab[NE + e];
                for (int u = u0 + ((F.bid - (u0 % F.G) + F.G) % F.G); u < u0 + nu; u += F.G) {
                    const int ul = u - u0, rt = ul >> 4, ct = ul & 15;
                    const bf16* Ap = Ab + (size_t)(off + rt * 128) * DE; const float* wd = wdown + (size_t)e * DE * DM + ct * 128;
                    float acc[4][8];
                    ngemm_tile<true, false>(sm, DE, [&](int i, int k) { return bf2f(Ap[(size_t)i * DE + k]); }, [&](int k, int j) { return bf2f((bf16)f2bf(wd[(size_t)k * DM + j])); }, acc);
#pragma unroll
                    for (int r = 0; r < 4; ++r) { bf16* o = Yb + (size_t)(off + rt * 128 + ty * 4 + r) * DM + ct * 128 + tx * 8;
                        u32x4 w; w.x = pk2(acc[r][0], acc[r][1]); w.y = pk2(acc[r][2], acc[r][3]); w.z = pk2(acc[r][4], acc[r][5]); w.w = pk2(acc[r][6], acc[r][7]); *(u32x4*)o = w; }
                }
                u0 += nu;
            }
                  }
        }
}
        SEAM(PB + 2);

        if (IN(PB + 3)) {
            PHASE_IDS();
#pragma unroll 1
        for (int rep_ = 0; rep_ <= ((REPMASK >> 9) & 1); ++rep_) {
            LAS int* tab = (LAS int*)(F.lds + MISC_OFF + 1024); moe_load_tab(tab, cnt, PT);
            float* xo = layer == 0 ? XB : F.out; const float* fg = args.in[6];
            const f32x4* grn = (const f32x4*)fg + PL;
            f32x4 gi8[8];
#pragma unroll
            for (int j = 0; j < 8; ++j) { const f32x4 g_ = ((const f32x4*)mg)[PL + 64 * j]; gi8[j] = (f32x4){1.0f / g_.x, 1.0f / g_.y, 1.0f / g_.z, 1.0f / g_.w}; }
            for (int tok0 = gw * 2; tok0 < NTOK; tok0 += NGW * 2) {
                f32x4 xv[2][8]; u32x2 xh[2][8], ya[2][8], yb[2][8]; float w1[2], w2[2];
#pragma unroll
                for (int r = 0; r < 2; ++r) { const int tok = tok0 + r;
                    const int e1 = SLOT[tok * 4], p1 = SLOT[tok * 4 + 1], e2 = SLOT[tok * 4 + 2], p2 = SLOT[tok * 4 + 3]; w1[r] = SLOTW[tok * 2]; w2[r] = SLOTW[tok * 2 + 1];
                    const u32x2* y1 = (const u32x2*)(Yb + (size_t)(tab[NE + e1] + p1) * DM) + PL; const u32x2* y2 = (const u32x2*)(Yb + (size_t)(tab[NE + e2] + p2) * DM) + PL;
                    const u32x2* xr = (const u32x2*)(XAh + (size_t)tok * DM) + PL;
#pragma unroll
                    for (int j = 0; j < 8; ++j) { xh[r][j] = xr[64 * j]; ya[r][j] = y1[64 * j]; yb[r][j] = y2[64 * j]; } }
#pragma unroll
                for (int r = 0; r < 2; ++r) { const int tok = tok0 + r; float sq = 0.f;
#pragma unroll
                    for (int j = 0; j < 8; ++j) { const u32x2 a = ya[r][j], b = yb[r][j]; f32x4 x = unpk4(xh[r][j]) * gi8[j];
                        x.x += w1[r] * bf2f((bf16)(a.x & 0xffff)) + w2[r] * bf2f((bf16)(b.x & 0xffff)); x.y += w1[r] * bf2f((bf16)(a.x >> 16)) + w2[r] * bf2f((bf16)(b.x >> 16));
                        x.z += w1[r] * bf2f((bf16)(a.y & 0xffff)) + w2[r] * bf2f((bf16)(b.y & 0xffff)); x.w += w1[r] * bf2f((bf16)(a.y >> 16)) + w2[r] * bf2f((bf16)(b.y >> 16));
                        xv[r][j] = x; sq += (x.x * x.x + x.y * x.y) + (x.z * x.z + x.w * x.w);
                        if (layer == 0) { u32x2 w; w.x = cvtpk(x.x, x.y); w.y = cvtpk(x.z, x.w); ((u32x2*)(XBh + (size_t)tok * DM))[PL + 64 * j] = w; } else ((f32x4*)(F.out + (size_t)tok * DM))[PL + 64 * j] = x; }
                    if (layer == 0) { const float rstd = 1.0f / sqrtf(wave_sum(sq) * (1.f / DM) + EPS); if (PL == 0) RS2[tok] = rstd; } }
            }
        }
}
        if (layer == 0) {
            SEAM(9);
            if (IN(10)) {
                PHASE_IDS();
#pragma unroll 1
        for (int rep_ = 0; rep_ <= ((REPMASK >> 10) & 1); ++rep_) {
              if constexpr (FASTMASK & 16) {
                const int wid = PW, lane = PL;
                constexpr int NU = 8 * 8 * 8;
                for (int u = vcu; u < NU; u += F.G) {
                    const int pn = u & 7, ip = (u >> 3) & 7, b = u >> 6;
                    GldsKc al, bl;
                    al.init(XBh, [&](int R) { int sq = 128 * ip + (R & 127); if (R >= 128) sq = (sq == 0) ? 1024 : (SEQ - sq); return ((b << 11) + sq) * DM; }, PT);
                    bl.init(WpT, [&](int R) { return (pn * 256 + R) * DM; }, PT);
                    f32x4 acc[8][4];
                    fgemm2<1, 0>(F.lds, al, bl, DM / 64, acc, PT);
                    EPI_IDS();
#pragma unroll
                    for (int m = 0; m < 4; ++m) { const int sq = 128 * ip + wr * 64 + m * 16 + fr; const int sm_ = (sq == 0) ? 1024 : (SEQ - sq);
                        const float rs1 = RS2[(b << 11) + sq], rs2 = RS2[(b << 11) + sm_];
                        bf16* o1 = VSYM + (size_t)((b << 11) + sq) * DM + pn * 256 + wc * 64 + 4 * fq; bf16* o2 = VSYM + (size_t)((b << 11) + sm_) * DM + pn * 256 + wc * 64 + 4 * fq;
#pragma unroll
                        for (int n = 0; n < 4; ++n) { float v1[4], v2[4];
#pragma unroll
                            for (int j = 0; j < 4; ++j) { const int jj = wc * 64 + n * 16 + 4 * fq + j; const float sg = (jj > 128) ? -1.f : 1.f; const float a1 = acc[m][n][j] * rs1, a2 = acc[m + 4][n][j] * rs2;
                                if (sq == 0) { v1[j] = (jj > 128) ? 0.f : 2.f * a1; v2[j] = (jj > 128) ? 0.f : 2.f * a2; } else { v1[j] = a1 + sg * a2; v2[j] = sg * v1[j]; } }
                            u32x2 w1, w2; w1.x = cvtpk(v1[0], v1[1]); w1.y = cvtpk(v1[2], v1[3]); w2.x = cvtpk(v2[0], v2[1]); w2.y = cvtpk(v2[2], v2[3]);
                            *(u32x2*)(o1 + n * 16) = w1; *(u32x2*)(o2 + n * 16) = w2; } }
                }
              } else {
                LAS float* sm = (LAS float*)F.lds; const int ty = PT >> 4, tx = PT & 15;
                const int NU = (NTOK / 128) * (DM / 128);
                for (int u = F.bid; u < NU; u += F.G) {
                    const int pm = u / (DM / 128), pn = u % (DM / 128); const int b = pm >> 4, s0 = (pm & 15) * 128;
                    float acc1[4][8], acc2[4][8];
                    const bf16* Bp = WpT + (size_t)pn * 128 * DM;
                    ngemm_tile<true, true>(sm, DM, [&](int i, int k) { return bf2f(Hb[(size_t)((b << 11) + s0 + i) * DM + k]); }, [&](int k, int j) { return bf2f(Bp[(size_t)j * DM + k]); }, acc1);
                    ngemm_tile<true, true>(sm, DM, [&](int i, int k) { return bf2f(Hb[(size_t)((b << 11) + ((SEQ - (s0 + i)) & 2047)) * DM + k]); }, [&](int k, int j) { return bf2f(Bp[(size_t)j * DM + k]); }, acc2);
#pragma unroll
                    for (int r = 0; r < 4; ++r) { bf16* o = VSYM + (size_t)((b << 11) + s0 + ty * 4 + r) * DM + pn * 128 + tx * 8; float a[8];
#pragma unroll
                        for (int q = 0; q < 8; ++q) { const int col = pn * 128 + tx * 8 + q; const float sg = ((col & 255) > 128) ? -1.f : 1.f; a[q] = acc1[r][q] + sg * acc2[r][q]; }
                        u32x4 w; w.x = pk2(a[0], a[1]); w.y = pk2(a[2], a[3]); w.z = pk2(a[4], a[5]); w.w = pk2(a[6], a[7]); *(u32x4*)o = w; }
                }
                          }
            }
}
            SEAM(10);
            if (IN(11)) {
                PHASE_IDS();
#pragma unroll 1
        for (int rep_ = 0; rep_ <= ((REPMASK >> 11) & 1); ++rep_) {
              if constexpr (FASTMASK & 32) {
                const int wid = PW, lane = PL;
                constexpr int NU = 8 * 8 * 8;
                for (int u = vcu; u < NU; u += F.G) {
                    const int pn = u & 7, kt1 = (u >> 3) & 7, b = u >> 6;
                    GldsKc al; KnBf16Loader bl;
                    al.init(HART, [&](int R) { return (kt1 * 256 + R) * SEQ; }, PT);
                    bl.init(VSYM, (unsigned)(((b << 11) + wid * 2 + (lane >> 5)) * DM + pn * 256 + 8 * (lane & 31)), DM);
                    f32x4 acc[8][4];
                    fgemm2<0, 2>(F.lds, al, bl, SEQ / 64, acc, PT);
                    EPI_IDS();
#pragma unroll
                    for (int m = 0; m < 8; ++m) { bf16* o = Zb + (size_t)((b << 11) + kt1 * 256 + wr * 128 + m * 16 + fr) * DM + pn * 256 + wc * 64 + 4 * fq;
#pragma unroll
                        for (int n = 0; n < 4; ++n) { u32x2 w; w.x = cvtpk(acc[m][n][0], acc[m][n][1]); w.y = cvtpk(acc[m][n][2], acc[m][n][3]); *(u32x2*)(o + n * 16) = w; } }
                }
              } else {
                LAS float* sm = (LAS float*)F.lds; const int ty = PT >> 4, tx = PT & 15;
                const int NU = (NTOK / 128) * (DM / 128);
                for (int u = F.bid; u < NU; u += F.G) {
                    const int pm = u / (DM / 128), pn = u % (DM / 128); const int b = pm >> 4, k10 = (pm & 15) * 128;
                    float acc[4][8];
                    const bf16* Ap = HART + (size_t)k10 * SEQ; const bf16* Bp = VSYM + (size_t)(b << 11) * DM + pn * 128;
                    ngemm_tile<true, false>(sm, SEQ, [&](int i, int k) { return bf2f(Ap[(size_t)i * SEQ + k]); }, [&](int k, int j) { return bf2f(Bp[(size_t)k * DM + j]); }, acc);
#pragma unroll
                    for (int r = 0; r < 4; ++r) { bf16* o = Zb + (size_t)((b << 11) + k10 + ty * 4 + r) * DM + pn * 128 + tx * 8;
                        u32x4 w; w.x = pk2(acc[r][0], acc[r][1]); w.y = pk2(acc[r][2], acc[r][3]); w.z = pk2(acc[r][4], acc[r][5]); w.w = pk2(acc[r][6], acc[r][7]); *(u32x4*)o = w; }
                }
                          }
            }
}
            SEAM(11);
            if (IN(12)) {
                PHASE_IDS();
#pragma unroll 1
        for (int rep_ = 0; rep_ <= ((REPMASK >> 12) & 1); ++rep_) {
              if constexpr (FASTMASK & 64) {
                const int wid = PW, lane = PL;
                constexpr int NCT = DM / 256, NU = (NTOK / 256) * NCT;
                for (int u = vcu; u < NU; u += F.G) {
                    const int pm = u / NCT, pn = u % NCT;
                    GldsKc al, bl;
                    al.init(Zb, [&](int R) { return (pm * 256 + R) * DM; }, PT);
                    bl.init(W2T, [&](int R) { return (pn * 256 + R) * DM; }, PT);
                    f32x4 acc[8][4];
                    fgemm2<0, 0>(F.lds, al, bl, DM / 64, acc, PT);
                    EPI_IDS();
                    f32x4 gm[4];
#pragma unroll
                    for (int n = 0; n < 4; ++n) gm[n] = *(const f32x4*)(args.in[9] + DM + pn * 256 + wc * 64 + n * 16 + 4 * fq);
#pragma unroll
                    for (int mh = 0; mh < 2; ++mh) {
                        u32x2 xr[4][4];
#pragma unroll
                        for (int m = 0; m < 4; ++m) { const size_t off = (size_t)(pm * 256 + wr * 128 + (mh * 4 + m) * 16 + fr) * DM + pn * 256 + wc * 64 + 4 * fq;
#pragma unroll
                            for (int n = 0; n < 4; ++n) xr[m][n] = *(const u32x2*)(XBh + off + n * 16); }
#pragma unroll
                        for (int m = 0; m < 4; ++m) { const int row = pm * 256 + wr * 128 + (mh * 4 + m) * 16 + fr; const size_t off = (size_t)row * DM + pn * 256 + wc * 64 + 4 * fq; float ss = 0.f;
#pragma unroll
                            for (int n = 0; n < 4; ++n) { const f32x4 v = unpk4(xr[m][n]) + acc[mh * 4 + m][n]; const f32x4 vg = v * gm[n]; u32x2 w; w.x = cvtpk(vg.x, vg.y); w.y = cvtpk(vg.z, vg.w); *(u32x2*)(XAh + off + n * 16) = w; ss += (v.x * v.x + v.y * v.y) + (v.z * v.z + v.w * v.w); }
                            ss += xshfl<16>(ss); ss = half_sum(ss); if (fq == 0) SSQ[row * 32 + pn * 4 + wc] = ss; } }
                }
              } else {
                LAS float* sm = (LAS float*)F.lds; const int ty = PT >> 4, tx = PT & 15;
                const int NU = (NTOK / 128) * (DM / 128);
                for (int u = F.bid; u < NU; u += F.G) {
                    const int pm = u / (DM / 128), pn = u % (DM / 128);
                    float acc[4][8];
                    const bf16* Ap = Zb + (size_t)pm * 128 * DM; const bf16* Bp = W2T + (size_t)pn * 128 * DM;
                    ngemm_tile<true, true>(sm, DM, [&](int i, int k) { return bf2f(Ap[(size_t)i * DM + k]); }, [&](int k, int j) { return bf2f(Bp[(size_t)j * DM + k]); }, acc);
#pragma unroll
                    for (int r = 0; r < 4; ++r) { const size_t off = (size_t)(pm * 128 + ty * 4 + r) * DM + pn * 128 + tx * 8;
                        const f32x4 x0 = *(const f32x4*)(XB + off), x1 = *(const f32x4*)(XB + off + 4);
                        *(f32x4*)(XA + off) = (f32x4){x0.x + acc[r][0], x0.y + acc[r][1], x0.z + acc[r][2], x0.w + acc[r][3]};
                        *(f32x4*)(XA + off + 4) = (f32x4){x1.x + acc[r][4], x1.y + acc[r][5], x1.z + acc[r][6], x1.w + acc[r][7]}; }
                }
                          }
            }
}
            SEAM(12);
        }
    }
#undef IN
#undef SEAM
}

extern "C" void kernel_launch(void* const* d_in, const int* in_sizes, int n_in, void* d_out, int out_size, void* d_ws, size_t ws_size, hipStream_t stream) {
    static int grid = 0;
    if (grid == 0) {
        if (n_in != 17 || ws_size < WS_END) { fprintf(stderr, "kernel_launch: unexpected n_in %d / ws %zu\n", n_in, ws_size); grid = -1; return; }
        int dev = 0, cus = 0, per_cu = 0;
        hipGetDevice(&dev); hipDeviceGetAttribute(&cus, hipDeviceAttributeMultiprocessorCount, dev);
        if (hipFuncSetAttribute((const void*)mega, hipFuncAttributeMaxDynamicSharedMemorySize, LDS_BYTES) != hipSuccess) { fprintf(stderr, "kernel_launch: hipFuncSetAttribute failed\n"); grid = -1; return; }
        if (hipOccupancyMaxActiveBlocksPerMultiprocessor(&per_cu, (const void*)mega, NTHR, LDS_BYTES) != hipSuccess || per_cu < 1) { fprintf(stderr, "kernel_launch: occupancy query says %d\n", per_cu); }
        (void)hipGetLastError();
        grid = cus;
    }
    if (grid < 0) return;
    hipMemsetAsync((char*)d_ws + WS_CTL, 0, CTL_BYTES, stream);
    Args a{};
    for (int i = 0; i < 17; ++i) a.in[i] = (const float*)d_in[i];
    a.out = (float*)d_out; a.ws = (unsigned char*)d_ws; a.ph_lo = 0; a.ph_hi = 17;
    hipLaunchKernelGGL(mega, dim3(grid), dim3(NTHR), LDS_BYTES, stream, a);
}
```
